# Optimizing an MI355X kernel written in HIP

```python
import jax, jax.numpy as jnp
from jax import lax
import numpy as np

D_MODEL = 2048
BATCH = 8
SEQ = 2048
DEPTH = 2

N_MIXERS = 2
N_HEADS = 16
HEAD_DIM = D_MODEL // N_HEADS
Q_BLOCK = 128
MOBA_BLOCK = 256
MOBA_TOPK = 3
MOBA_Q_CHUNK = 8
D_FF = 5632
N_EXPERTS = 8
MOE_TOPK = 2
D_FF_EXPERT = 7168
EPS = 1e-6

kernel_name = "hybrid_stickbreak_moba_moe_adaln"


def rms_norm(x, g):
    xf = x.astype(jnp.float32)
    y = xf * lax.rsqrt(jnp.mean(xf * xf, axis=-1, keepdims=True) + EPS)
    return (y * g.astype(jnp.float32)).astype(x.dtype)


def alibi_slopes(n_heads):
    return jnp.exp2(-8.0 * jnp.arange(1, n_heads + 1, dtype=jnp.float32) / n_heads)


def swiglu(h, w_in, w_out):
    gu = h @ w_in
    g, u = jnp.split(gu, 2, axis=-1)
    return (jax.nn.silu(g) * u) @ w_out


def stick_breaking_attention(q, k, v):
    B, H, S, d = q.shape
    scale = d ** -0.5
    outs = []
    for start in range(0, S, Q_BLOCK):
        end = start + Q_BLOCK
        qb = q[:, :, start:end]
        kb = k[:, :, :end]
        vb = v[:, :, :end]
        z = jnp.einsum('bhqd,bhkd->bhqk', qb, kb, preferred_element_type=jnp.float32) * scale
        t_pos = start + jnp.arange(Q_BLOCK)[:, None]
        s_pos = jnp.arange(end)[None, :]
        past = s_pos < t_pos
        log_keep = jnp.where(past, jax.nn.log_sigmoid(-z), 0.0)
        later = lax.cumsum(log_keep, axis=3, reverse=True) - log_keep
        a = jnp.where(past, jnp.exp(jax.nn.log_sigmoid(z) + later), 0.0)
        outs.append(jnp.einsum('bhqk,bhkd->bhqd', a.astype(vb.dtype), vb))
    return jnp.concatenate(outs, axis=2)


def moba_attention(q, k, v, slopes):
    B, H, S, d = q.shape
    scale = d ** -0.5
    nb = -(-S // MOBA_BLOCK)
    pad = nb * MOBA_BLOCK - S
    kp = jnp.pad(k, ((0, 0), (0, 0), (0, pad), (0, 0)))
    vp = jnp.pad(v, ((0, 0), (0, 0), (0, pad), (0, 0)))
    kblk = kp.reshape(B, H, nb, MOBA_BLOCK, d)
    vblk = vp.reshape(B, H, nb, MOBA_BLOCK, d)
    kmean = jnp.mean(kblk.astype(jnp.float32), axis=3)
    t = jnp.arange(S)
    own = t // MOBA_BLOCK
    gate = jnp.einsum('bhsd,bhnd->bhsn', q.astype(jnp.float32), kmean)
    fully_past = jnp.arange(nb)[None, :] < own[:, None]
    gate = jnp.where(fully_past, gate, -jnp.inf)
    n_sel = min(MOBA_TOPK, nb)
    top_val, top_idx = lax.top_k(gate, n_sel)
    sel_valid = jnp.isfinite(top_val)
    own_idx = jnp.broadcast_to(own[None, None, :, None], (B, H, S, 1)).astype(top_idx.dtype)
    idx = jnp.concatenate([top_idx, own_idx], axis=-1)
    valid = jnp.concatenate([sel_valid, jnp.ones((B, H, S, 1), dtype=bool)], axis=-1)

    nc = S // MOBA_Q_CHUNK

    def to_chunks(a):
        a = a.reshape(B, H, nc, MOBA_Q_CHUNK, *a.shape[3:])
        return jnp.moveaxis(a, 2, 0)

    b_ix = jnp.arange(B)[:, None, None, None]
    h_ix = jnp.arange(H)[None, :, None, None]
    offs = jnp.arange(MOBA_BLOCK)
    slope = slopes[None, :, None, None, None]

    def chunk(args):
        qc, idxc, validc, tc = args
        kg = kblk[b_ix, h_ix, idxc]
        vg = vblk[b_ix, h_ix, idxc]
        pos = idxc[..., None] * MOBA_BLOCK + offs
        dist = tc[None, None, :, None, None] - pos
        mask = validc[..., None] & (dist >= 0)
        s = jnp.einsum('bhqd,bhqnkd->bhqnk', qc, kg, preferred_element_type=jnp.float32) * scale
        s = s - slope * dist.astype(jnp.float32)
        s = jnp.where(mask, s, -jnp.inf)
        p = jax.nn.softmax(s.reshape(B, H, MOBA_Q_CHUNK, -1), axis=-1).reshape(s.shape)
        return jnp.einsum('bhqnk,bhqnkd->bhqd', p.astype(vg.dtype), vg)

    out = lax.map(chunk, (to_chunks(q), to_chunks(idx), to_chunks(valid),
                          t.reshape(nc, MOBA_Q_CHUNK)))
    return jnp.moveaxis(out, 0, 2).reshape(B, H, S, d)


def moe_swiglu(h, w_router, w_in, w_out):
    logits = jnp.einsum('nd,de->ne', h, w_router, preferred_element_type=jnp.float32)
    top_val, top_idx = lax.top_k(logits, MOE_TOPK)
    top_w = jax.nn.softmax(top_val, axis=-1)
    gates = jnp.sum(jax.nn.one_hot(top_idx, N_EXPERTS, dtype=jnp.float32) * top_w[..., None], axis=1)
    y = jnp.zeros_like(h)
    for e in range(N_EXPERTS):
        y = y + gates[:, e:e + 1].astype(h.dtype) * swiglu(h, w_in[e], w_out[e])
    return y


def setup_inputs(seed: int = 0) -> dict:
    key = jax.random.key(seed)
    ks = jax.random.split(key, 16)
    n_even = (DEPTH + 1) // 2
    n_odd = DEPTH // 2
    D = D_MODEL
    nrm = jax.random.normal
    f32 = jnp.float32
    return {
        "x": nrm(ks[0], (BATCH, SEQ, D), f32),
        "c": nrm(ks[1], (BATCH, D), f32),
        "w_ada": nrm(ks[2], (DEPTH, D, 6 * D), f32) * (0.5 * D ** -0.5),
        "b_ada": nrm(ks[3], (DEPTH, 6 * D), f32) * 0.02,
        "attn_norm": 1.0 + 0.1 * nrm(ks[4], (DEPTH, D), f32),
        "ffn_norm": 1.0 + 0.1 * nrm(ks[5], (DEPTH, D), f32),
        "w_qkv": nrm(ks[6], (DEPTH, D, 3 * D), f32) * D ** -0.5,
        "w_o": nrm(ks[7], (DEPTH, D, D), f32) * D ** -0.5,
        "qk_norm_q": 1.0 + 0.1 * nrm(ks[8], (n_odd, HEAD_DIM), f32),
        "qk_norm_k": 1.0 + 0.1 * nrm(ks[9], (n_odd, HEAD_DIM), f32),
        "ffn_w_in": nrm(ks[10], (n_even, D, 2 * D_FF), f32) * D ** -0.5,
        "ffn_w_out": nrm(ks[11], (n_even, D_FF, D), f32) * D_FF ** -0.5,
        "router_w": nrm(ks[12], (n_odd, D, N_EXPERTS), f32) * D ** -0.5,
        "moe_w_in": nrm(ks[13], (n_odd, N_EXPERTS, D, 2 * D_FF_EXPERT), f32) * D ** -0.5,
        "moe_w_out": nrm(ks[14], (n_odd, N_EXPERTS, D_FF_EXPERT, D), f32) * D_FF_EXPERT ** -0.5,
    }


def reference(x, c, w_ada, b_ada, attn_norm, ffn_norm, w_qkv, w_o, qk_norm_q, qk_norm_k,
              ffn_w_in, ffn_w_out, router_w, moe_w_in, moe_w_out):
    B, S, D = x.shape
    slopes = alibi_slopes(N_HEADS)
    for i in range(DEPTH):
        mod = (c @ w_ada[i] + b_ada[i])[:, None, :]
        sh_a, sc_a, g_a, sh_f, sc_f, g_f = jnp.split(mod, 6, axis=-1)
        h = rms_norm(x, attn_norm[i]) * (1.0 + sc_a) + sh_a
        qkv = (h @ w_qkv[i]).reshape(B, S, 3, N_HEADS, HEAD_DIM)
        q = jnp.swapaxes(qkv[:, :, 0], 1, 2)
        k = jnp.swapaxes(qkv[:, :, 1], 1, 2)
        v = jnp.swapaxes(qkv[:, :, 2], 1, 2)
        if i % N_MIXERS == 0:
            o = stick_breaking_attention(q, k, v)
        else:
            j = i // N_MIXERS
            q = rms_norm(q, qk_norm_q[j])
            k = rms_norm(k, qk_norm_k[j])
            o = moba_attention(q, k, v, slopes)
        o = jnp.swapaxes(o, 1, 2).reshape(B, S, D)
        x = x + g_a * (o @ w_o[i])
        h = rms_norm(x, ffn_norm[i]) * (1.0 + sc_f) + sh_f
        if i % 2 == 0:
            y = swiglu(h, ffn_w_in[i // 2], ffn_w_out[i // 2])
        else:
            y = moe_swiglu(h.reshape(B * S, D), router_w[i // 2], moe_w_in[i // 2],
                           moe_w_out[i // 2]).reshape(B, S, D)
        x = x + g_f * y
    return x
```

```cpp
#include <hip/hip_runtime.h>
#include <cstdio>
#include <cstdint>

#ifndef MK_ONE_LAUNCH
#define MK_ONE_LAUNCH 1
#endif

namespace pg8 {
#define PG8_LAS __attribute__((address_space(3)))
typedef unsigned short bf16_t;
typedef short bf16x8 __attribute__((ext_vector_type(8)));
typedef float f32x4 __attribute__((ext_vector_type(4)));
typedef unsigned u32x4 __attribute__((ext_vector_type(4)));
constexpr int BM = 256, BK = 64, HALF = 128, HTB = HALF * BK * 2  , STAGE_BYTES = 8 * HTB, NXCD = 8;

__host__ __device__ __forceinline__ int lds_byte(int r, int c) { const int st = (r >> 4) * 2 + (c >> 5), rr = r & 15, cc = c & 31, ob = rr * 64 + cc * 2; return st * 1024 + (ob ^ (((ob >> 9) & 1) << 5)); }
__host__ __device__ __forceinline__ void stage_rc(int b, int& R, int& C) { const int st = b / 1024, sb = b % 1024, swz = sb ^ (((sb >> 9) & 1) << 5); R = (st >> 1) * 16 + swz / 64; C = (st & 1) * 32 + (swz % 64) / 2; }
__host__ __device__ __forceinline__ int perm32(int rho) { const int n = rho >> 4, i = rho & 15; return 8 * (i >> 2) + 4 * n + (i & 3); }

__device__ __forceinline__ void glds16s(const void* sbase, unsigned voff, unsigned lds_dst) { unsigned keep;
    asm volatile("s_mov_b32 %0, m0\n\ts_mov_b32 m0, %3\n\ts_nop 0\n\tglobal_load_lds_dwordx4 %1, %2\n\ts_mov_b32 m0, %0" : "=&s"(keep) : "v"(voff), "s"(sbase), "s"(lds_dst) : "memory"); }
struct Unit { int pm, pn, om, on, aux, koff; };
typedef int v4i32 __attribute__((ext_vector_type(4))); typedef int v8i32 __attribute__((ext_vector_type(8)));
template <int MODE> struct AccSel { typedef f32x4 T; }; template <> struct AccSel<2> { typedef v4i32 T; };
struct Gemm { const bf16_t* A; const bf16_t* Bt; int M, N, K; int pitch; };

__device__ __forceinline__ void remap_tile(int wgid, int nM, int nN, int nwg, int WGM, int& tm, int& tn) {
    { const int q = nwg / NXCD, r = nwg % NXCD, xcd = wgid % NXCD, off = wgid / NXCD; wgid = (xcd < r ? xcd * (q + 1) : r * (q + 1) + (xcd - r) * q) + off; }
    const int nig = WGM * nN, gid = wgid / nig, fm = gid * WGM, gsz = (nM - fm) < WGM ? (nM - fm) : WGM;
    tm = fm + ((wgid % nig) % gsz); tn = (wgid % nig) / gsz;
}
struct StaticOrder {
    int nM, nN, nwg, G, c, wgm;
    __device__ void init(int M, int N, int G_, int c_, int wgm_ = 4) { nM = M / BM; nN = N / BM; nwg = nM * nN; G = G_; c = c_; wgm = wgm_; }
    __device__ __forceinline__ bool next(int i, Unit& u) const {
        const long L = (long)i * G + c; if (L >= nwg) return false;
        int tm, tn; remap_tile((int)L, nM, nN, nwg, wgm, tm, tn);
        u.pm = tm; u.pn = tn; u.om = tm; u.on = tn; u.aux = 0; u.koff = 0; return true;
    }
    __device__ __forceinline__ void a_ready(const Unit&) const {}
    __device__ __forceinline__ void done(const Unit&) const {}
};
struct MoeOrder {
    int nN, nwg, G, c, R, wgm, xil;
    int p1, p2, p3, p4, p5, p6, p7;
    int a_cap;
    int b_per_e;
    __device__ __forceinline__ bool next(int i, Unit& u) const {
        const long L = (long)i * G + c; if (!xil && L >= nwg) return false;
        int rt, tn;
        if (xil) {
            const int xcd = (int)(L & 7), off = (int)(L >> 3), wg = ((off >> 5) * 8 + xcd) * 32 + (off & 31); if (wg >= nwg) return false;
            const int nig = wgm * nN, gid = wg / nig, fm = gid * wgm, gsz = (R - fm) < wgm ? (R - fm) : wgm; rt = fm + ((wg % nig) % gsz); tn = (wg % nig) / gsz; }
        else remap_tile((int)L, R, nN, nwg, wgm, rt, tn);
        const int e = (rt >= p1) + (rt >= p2) + (rt >= p3) + (rt >= p4) + (rt >= p5) + (rt >= p6) + (rt >= p7);
        int base = 0; base = e >= 1 ? p1 : base; base = e >= 2 ? p2 : base; base = e >= 3 ? p3 : base; base = e >= 4 ? p4 : base; base = e >= 5 ? p5 : base; base = e >= 6 ? p6 : base; base = e >= 7 ? p7 : base;
        const int mt = rt - base;
        u.pm = a_cap ? e * a_cap + mt : rt; u.pn = e * b_per_e + tn; u.om = rt; u.on = tn; u.aux = e * 16384 + mt * 256; u.koff = 0; return true;
    }
    __device__ __forceinline__ void a_ready(const Unit&) const {}
    __device__ __forceinline__ void done(const Unit&) const {}
};

struct MoeTailOrder {
    int G, c, R, kchunk;
    int p1, p2, p3, p4, p5, p6, p7;
    __device__ __forceinline__ bool next(int i, Unit& u) const {
        const int L = i * G + c; if (L >= (R - 128) * 32) return false;
        const int kc = L & 3, tn = (L >> 2) & 7, x = L >> 5, rt = 128 + x;
        const int e = (rt >= p1) + (rt >= p2) + (rt >= p3) + (rt >= p4) + (rt >= p5) + (rt >= p6) + (rt >= p7);
        int base = 0; base = e >= 1 ? p1 : base; base = e >= 2 ? p2 : base; base = e >= 3 ? p3 : base; base = e >= 4 ? p4 : base; base = e >= 5 ? p5 : base; base = e >= 6 ? p6 : base; base = e >= 7 ? p7 : base;
        const int mt = rt - base;
        u.pm = rt; u.pn = e * 8 + tn; u.om = kc * 8 + x; u.on = tn; u.aux = e * 16384 + mt * 256; u.koff = kc * kchunk; return true;
    }
    __device__ __forceinline__ void a_ready(const Unit&) const {}
    __device__ __forceinline__ void done(const Unit&) const {}
};

typedef float f32x2c __attribute__((ext_vector_type(2))); typedef __bf16 bf16x2c __attribute__((ext_vector_type(2)));
__device__ __forceinline__ unsigned cvt_pk_bf16(float lo, float hi) { f32x2c v = {lo, hi}; bf16x2c b = __builtin_convertvector(v, bf16x2c); return __builtin_bit_cast(unsigned, b); }

struct EpiBf16 {
    static constexpr bool PERM = true, AFTER_DRAIN = false;
    bf16_t* O; int ldc;
    __device__ __forceinline__ void operator()(const f32x4 (&acc)[2][2][4][2], const Unit& u, int wr, int wc, int fr, int fq) const {
        const int row0 = u.om * BM + wr * 64 + fr, col0 = u.on * BM + wc * 32 + 8 * fq;
#pragma unroll
        for (int ai = 0; ai < 2; ++ai)
#pragma unroll
            for (int m = 0; m < 4; ++m) { bf16_t* rowp = O + (size_t)(row0 + ai * HALF + m * 16) * ldc + col0;
#pragma unroll
                for (int bj = 0; bj < 2; ++bj) { const f32x4 v0 = acc[ai][bj][m][0], v1 = acc[ai][bj][m][1];
                    u32x4 w; w.x = cvt_pk_bf16(v0[0], v0[1]); w.y = cvt_pk_bf16(v0[2], v0[3]); w.z = cvt_pk_bf16(v1[0], v1[1]); w.w = cvt_pk_bf16(v1[2], v1[3]);
                    *(u32x4*)(rowp + bj * HALF) = w; } }
    }
};
struct EpiBf16RowScale {
    static constexpr bool PERM = true, AFTER_DRAIN = false;
    bf16_t* O; int ldc; const float* rs; float pre;
    __device__ __forceinline__ void operator()(const f32x4 (&acc)[2][2][4][2], const Unit& u, int wr, int wc, int fr, int fq) const {
        const int r0 = wr * 64 + fr, row0 = u.om * BM + r0, col0 = u.on * BM + wc * 32 + 8 * fq;
#pragma unroll
        for (int ai = 0; ai < 2; ++ai)
#pragma unroll
            for (int m = 0; m < 4; ++m) { bf16_t* rowp = O + (size_t)(row0 + ai * HALF + m * 16) * ldc + col0; const float s = rs[u.aux + r0 + ai * HALF + m * 16] * pre;
#pragma unroll
                for (int bj = 0; bj < 2; ++bj) { const f32x4 v0 = acc[ai][bj][m][0] * s, v1 = acc[ai][bj][m][1] * s;
                    u32x4 w; w.x = cvt_pk_bf16(v0[0], v0[1]); w.y = cvt_pk_bf16(v0[2], v0[3]); w.z = cvt_pk_bf16(v1[0], v1[1]); w.w = cvt_pk_bf16(v1[2], v1[3]);
                    *(u32x4*)(rowp + bj * HALF) = w; } }
    }
};
struct EpiF32RowScale {
    static constexpr bool PERM = false, AFTER_DRAIN = false;
    float* C; int ldc; const float* rs; float pre;
    __device__ __forceinline__ void operator()(const f32x4 (&acc)[2][2][4][2], const Unit& u, int wr, int wc, int fr, int fq) const {
        const int r0 = wr * 64 + fr, row0 = u.om * BM + r0, col0 = u.on * BM + wc * 32 + 4 * fq;
#pragma unroll
        for (int ai = 0; ai < 2; ++ai)
#pragma unroll
            for (int m = 0; m < 4; ++m) { float* rowp = C + (size_t)(row0 + ai * HALF + m * 16) * ldc + col0; const float s = rs[u.aux + r0 + ai * HALF + m * 16] * pre;
#pragma unroll
                for (int bj = 0; bj < 2; ++bj)
#pragma unroll
                    for (int n = 0; n < 2; ++n) *(f32x4*)(rowp + bj * HALF + n * 16) = acc[ai][bj][m][n] * s; }
    }
};
struct EpiResGate {
    static constexpr bool PERM = false, AFTER_DRAIN = false;
    const float* resid; float* out; int ldc; const float* gate; int gate_ld; int rows_per_b; float pre;
    __device__ __forceinline__ void operator()(const f32x4 (&acc)[2][2][4][2], const Unit& u, int wr, int wc, int fr, int fq) const {
        const int row0 = u.om * BM + wr * 64 + fr, col0 = u.on * BM + wc * 32 + 4 * fq;
        const float* gp = gate + (size_t)((u.om * BM) / rows_per_b) * gate_ld + col0;
        f32x4 gv[2][2];
#pragma unroll
        for (int bj = 0; bj < 2; ++bj)
#pragma unroll
            for (int n = 0; n < 2; ++n) gv[bj][n] = *(const f32x4*)(gp + bj * HALF + n * 16) * pre;
#pragma unroll
        for (int ai = 0; ai < 2; ++ai)
#pragma unroll
            for (int m = 0; m < 4; ++m) { const size_t off = (size_t)(row0 + ai * HALF + m * 16) * ldc + col0;
#pragma unroll
                for (int bj = 0; bj < 2; ++bj)
#pragma unroll
                    for (int n = 0; n < 2; ++n) { const f32x4 rv = *(const f32x4*)(resid + off + bj * HALF + n * 16); *(f32x4*)(out + off + bj * HALF + n * 16) = rv + gv[bj][n] * acc[ai][bj][m][n]; }
                if (m & 1) asm volatile("" ::: "memory"); }
    }
};
template <bool RESF32> struct EpiResGateB {
    static constexpr bool PERM = true, AFTER_DRAIN = false;
    const void* resid; bf16_t* out; int ldc; const float* gate; int gate_ld; int rows_per_b; float pre;
    __device__ __forceinline__ void operator()(const f32x4 (&acc)[2][2][4][2], const Unit& u, int wr, int wc, int fr, int fq) const {
        const int row0 = u.om * BM + wr * 64 + fr, col0 = u.on * BM + wc * 32 + 8 * fq;
        const float* gp = gate + (size_t)((u.om * BM) / rows_per_b) * gate_ld + col0;
        f32x4 gv[2][2];
#pragma unroll
        for (int bj = 0; bj < 2; ++bj)
#pragma unroll
            for (int n = 0; n < 2; ++n) gv[bj][n] = *(const f32x4*)(gp + bj * HALF + 4 * n) * pre;
#pragma unroll
        for (int ai = 0; ai < 2; ++ai)
#pragma unroll
            for (int m = 0; m < 4; ++m) { const size_t off = (size_t)(row0 + ai * HALF + m * 16) * ldc + col0;
#pragma unroll
                for (int bj = 0; bj < 2; ++bj) { f32x4 r0, r1;
                    if constexpr (RESF32) { r0 = *(const f32x4*)((const float*)resid + off + bj * HALF); r1 = *(const f32x4*)((const float*)resid + off + bj * HALF + 4); }
                    else { const u32x4 rb = *(const u32x4*)((const bf16_t*)resid + off + bj * HALF);
                        r0 = (f32x4){__builtin_bit_cast(float, rb.x << 16), __builtin_bit_cast(float, rb.x & 0xffff0000u), __builtin_bit_cast(float, rb.y << 16), __builtin_bit_cast(float, rb.y & 0xffff0000u)};
                        r1 = (f32x4){__builtin_bit_cast(float, rb.z << 16), __builtin_bit_cast(float, rb.z & 0xffff0000u), __builtin_bit_cast(float, rb.w << 16), __builtin_bit_cast(float, rb.w & 0xffff0000u)}; }
                    const f32x4 v0 = r0 + gv[bj][0] * acc[ai][bj][m][0], v1 = r1 + gv[bj][1] * acc[ai][bj][m][1];
                    u32x4 w; w.x = cvt_pk_bf16(v0[0], v0[1]); w.y = cvt_pk_bf16(v0[2], v0[3]); w.z = cvt_pk_bf16(v1[0], v1[1]); w.w = cvt_pk_bf16(v1[2], v1[3]);
                    *(u32x4*)(out + off + bj * HALF) = w; }
                if (m & 1) asm volatile("" ::: "memory"); }
    }
};
__device__ __forceinline__ unsigned cvt4_fp8(float a, float b, float c, float d) {
    a = __builtin_amdgcn_fmed3f(a, -448.f, 448.f); b = __builtin_amdgcn_fmed3f(b, -448.f, 448.f); c = __builtin_amdgcn_fmed3f(c, -448.f, 448.f); d = __builtin_amdgcn_fmed3f(d, -448.f, 448.f);
    int p = __builtin_amdgcn_cvt_pk_fp8_f32(a, b, 0, false); p = __builtin_amdgcn_cvt_pk_fp8_f32(c, d, p, true); return (unsigned)p; }
struct EpiSwiGLU {
    static constexpr bool PERM = true, AFTER_DRAIN = false;
    bf16_t* O; int ldc; float pre;
    __device__ __forceinline__ static float act(float g, float uu) { return g * uu * __builtin_amdgcn_rcpf(1.0f + __builtin_amdgcn_exp2f(-1.4426950408889634f * g)); }
    __device__ __forceinline__ void operator()(const f32x4 (&acc)[2][2][4][2], const Unit& u, int wr, int wc, int fr, int fq) const {
        const int row0 = u.om * BM + wr * 64 + fr, col0 = u.on * HALF + wc * 32 + 8 * fq;
#pragma unroll
        for (int ai = 0; ai < 2; ++ai)
#pragma unroll
            for (int m = 0; m < 4; ++m) { bf16_t* rowp = O + (size_t)(row0 + ai * HALF + m * 16) * ldc + col0;
                const f32x4 g0 = acc[ai][0][m][0] * pre, g1 = acc[ai][0][m][1] * pre, u0 = acc[ai][1][m][0] * pre, u1 = acc[ai][1][m][1] * pre;
                u32x4 w; w.x = cvt_pk_bf16(act(g0[0], u0[0]), act(g0[1], u0[1])); w.y = cvt_pk_bf16(act(g0[2], u0[2]), act(g0[3], u0[3]));
                w.z = cvt_pk_bf16(act(g1[0], u1[0]), act(g1[1], u1[1])); w.w = cvt_pk_bf16(act(g1[2], u1[2]), act(g1[3], u1[3]));
                *(u32x4*)rowp = w; }
    }
};
__device__ __forceinline__ f32x4 swiglu4p(const f32x4 ag, const f32x4 au, const float npl, const float ipp  ) {
    const f32x4 t = ag * npl;
    f32x4 e; e[0] = __builtin_amdgcn_exp2f(t[0]); e[1] = __builtin_amdgcn_exp2f(t[1]); e[2] = __builtin_amdgcn_exp2f(t[2]); e[3] = __builtin_amdgcn_exp2f(t[3]);
    const f32x4 d = e * ipp + ipp;
    f32x4 r; r[0] = __builtin_amdgcn_rcpf(d[0]); r[1] = __builtin_amdgcn_rcpf(d[1]); r[2] = __builtin_amdgcn_rcpf(d[2]); r[3] = __builtin_amdgcn_rcpf(d[3]);
    return (ag * au) * r;
}
struct EpiSwiGLU8 {
    static constexpr bool PERM = true, AFTER_DRAIN = false;
    unsigned char* O; int ldc; float pre;
    __device__ __forceinline__ void operator()(const f32x4 (&acc)[2][2][4][2], const Unit& u, int wr, int wc, int fr, int fq) const {
        const int row0 = u.om * BM + wr * 64 + fr, col0 = u.on * HALF + wc * 32 + 8 * fq;
        const float npl = -1.4426950408889634f * pre, pp = 1.0f / (pre * pre);
#pragma unroll
        for (int ai = 0; ai < 2; ++ai)
#pragma unroll
            for (int m = 0; m < 4; ++m) { unsigned char* rowp = O + (size_t)(row0 + ai * HALF + m * 16) * ldc + col0;
                const f32x4 h0 = swiglu4p(acc[ai][0][m][0], acc[ai][1][m][0], npl, pp), h1 = swiglu4p(acc[ai][0][m][1], acc[ai][1][m][1], npl, pp);
                typedef unsigned u32x2e __attribute__((ext_vector_type(2))); u32x2e w;
                w.x = cvt4_fp8(h0[0], h0[1], h0[2], h0[3]); w.y = cvt4_fp8(h1[0], h1[1], h1[2], h1[3]);
                *(u32x2e*)rowp = w; asm volatile("" ::: "memory"); }
    }
};
struct EpiSwiGLUi8 {
    static constexpr bool PERM = true, AFTER_DRAIN = false;
    bf16_t* O; int ldc; const float* rs; const float* cs;
    __device__ __forceinline__ void operator()(const v4i32 (&acc)[2][2][4][2], const Unit& u, int wr, int wc, int fr, int fq) const {
        const int row0 = u.om * BM + wr * 64 + fr, col0 = u.on * HALF + wc * 32 + 8 * fq, cb = u.on * BM + wc * 32 + 8 * fq;
        const f32x4 wg0 = *(const f32x4*)(cs + cb), wg1 = *(const f32x4*)(cs + cb + 4), wu0 = *(const f32x4*)(cs + cb + HALF), wu1 = *(const f32x4*)(cs + cb + HALF + 4);
#pragma unroll
        for (int ai = 0; ai < 2; ++ai)
#pragma unroll
            for (int m = 0; m < 4; ++m) { const int r = row0 + ai * HALF + m * 16; const float hs = rs[r]; bf16_t* rowp = O + (size_t)r * ldc + col0;
                const f32x4 g0 = __builtin_convertvector(acc[ai][0][m][0], f32x4) * (wg0 * hs), g1 = __builtin_convertvector(acc[ai][0][m][1], f32x4) * (wg1 * hs);
                const f32x4 u0 = __builtin_convertvector(acc[ai][1][m][0], f32x4) * (wu0 * hs), u1 = __builtin_convertvector(acc[ai][1][m][1], f32x4) * (wu1 * hs);
                u32x4 w; w.x = cvt_pk_bf16(EpiSwiGLU::act(g0[0], u0[0]), EpiSwiGLU::act(g0[1], u0[1])); w.y = cvt_pk_bf16(EpiSwiGLU::act(g0[2], u0[2]), EpiSwiGLU::act(g0[3], u0[3]));
                w.z = cvt_pk_bf16(EpiSwiGLU::act(g1[0], u1[0]), EpiSwiGLU::act(g1[1], u1[1])); w.w = cvt_pk_bf16(EpiSwiGLU::act(g1[2], u1[2]), EpiSwiGLU::act(g1[3], u1[3]));
                *(u32x4*)rowp = w; asm volatile("" ::: "memory"); }
    }
};
struct EpiSwiGLUi8f8 {
    static constexpr bool PERM = true, AFTER_DRAIN = false;
    unsigned char* O; int ldc; const float* rs; const float* cs;
    __device__ __forceinline__ void operator()(const v4i32 (&acc)[2][2][4][2], const Unit& u, int wr, int wc, int fr, int fq) const {
        const int row0 = u.om * BM + wr * 64 + fr, col0 = u.on * HALF + wc * 32 + 8 * fq, cb = u.on * BM + wc * 32 + 8 * fq;
        const f32x4 wg0 = *(const f32x4*)(cs + cb), wg1 = *(const f32x4*)(cs + cb + 4), wu0 = *(const f32x4*)(cs + cb + HALF), wu1 = *(const f32x4*)(cs + cb + HALF + 4);
#pragma unroll
        for (int ai = 0; ai < 2; ++ai)
#pragma unroll
            for (int m = 0; m < 4; ++m) { const int r = row0 + ai * HALF + m * 16; const float hs = rs[r]; unsigned char* rowp = O + (size_t)r * ldc + col0;
                const f32x4 g0 = __builtin_convertvector(acc[ai][0][m][0], f32x4) * (wg0 * hs), g1 = __builtin_convertvector(acc[ai][0][m][1], f32x4) * (wg1 * hs);
                const f32x4 u0 = __builtin_convertvector(acc[ai][1][m][0], f32x4) * (wu0 * hs), u1 = __builtin_convertvector(acc[ai][1][m][1], f32x4) * (wu1 * hs);
                typedef unsigned u32x2e __attribute__((ext_vector_type(2))); u32x2e w;
                const f32x4 h0 = swiglu4p(g0, u0, -1.4426950408889634f, 1.0f), h1 = swiglu4p(g1, u1, -1.4426950408889634f, 1.0f);
                w.x = cvt4_fp8(h0[0], h0[1], h0[2], h0[3]); w.y = cvt4_fp8(h1[0], h1[1], h1[2], h1[3]);
                *(u32x2e*)rowp = w; asm volatile("" ::: "memory"); }
    }
};
template <bool RESF32> struct EpiResGateBi8 {
    static constexpr bool PERM = true, AFTER_DRAIN = false;
    const void* resid; bf16_t* out; int ldc; const float* gate; int gate_ld; int rows_per_b; const float* rs; const float* cs;
    __device__ __forceinline__ void operator()(const v4i32 (&acc)[2][2][4][2], const Unit& u, int wr, int wc, int fr, int fq) const {
        const int row0 = u.om * BM + wr * 64 + fr, col0 = u.on * BM + wc * 32 + 8 * fq;
        const float* gp = gate + (size_t)((u.om * BM) / rows_per_b) * gate_ld + col0;
        f32x4 gv[2][2];
#pragma unroll
        for (int bj = 0; bj < 2; ++bj)
#pragma unroll
            for (int n = 0; n < 2; ++n) gv[bj][n] = *(const f32x4*)(gp + bj * HALF + 4 * n) * *(const f32x4*)(cs + col0 + bj * HALF + 4 * n);
#pragma unroll
        for (int ai = 0; ai < 2; ++ai)
#pragma unroll
            for (int m = 0; m < 4; ++m) { const int r = row0 + ai * HALF + m * 16; const float hs = rs[r]; const size_t off = (size_t)r * ldc + col0;
#pragma unroll
                for (int bj = 0; bj < 2; ++bj) { f32x4 r0, r1;
                    if constexpr (RESF32) { r0 = *(const f32x4*)((const float*)resid + off + bj * HALF); r1 = *(const f32x4*)((const float*)resid + off + bj * HALF + 4); }
                    else { const u32x4 rb = *(const u32x4*)((const bf16_t*)resid + off + bj * HALF);
                        r0 = (f32x4){__builtin_bit_cast(float, rb.x << 16), __builtin_bit_cast(float, rb.x & 0xffff0000u), __builtin_bit_cast(float, rb.y << 16), __builtin_bit_cast(float, rb.y & 0xffff0000u)};
                        r1 = (f32x4){__builtin_bit_cast(float, rb.z << 16), __builtin_bit_cast(float, rb.z & 0xffff0000u), __builtin_bit_cast(float, rb.w << 16), __builtin_bit_cast(float, rb.w & 0xffff0000u)}; }
                    const f32x4 v0 = r0 + (gv[bj][0] * hs) * __builtin_convertvector(acc[ai][bj][m][0], f32x4), v1 = r1 + (gv[bj][1] * hs) * __builtin_convertvector(acc[ai][bj][m][1], f32x4);
                    u32x4 w; w.x = cvt_pk_bf16(v0[0], v0[1]); w.y = cvt_pk_bf16(v0[2], v0[3]); w.z = cvt_pk_bf16(v1[0], v1[1]); w.w = cvt_pk_bf16(v1[2], v1[3]);
                    *(u32x4*)(out + off + bj * HALF) = w; }
                if (m & 1) asm volatile("" ::: "memory"); }
    }
};
struct EpiBf16i8 {
    static constexpr bool PERM = true, AFTER_DRAIN = false;
    bf16_t* O; int ldc; const float* rs; const float* cs;
    __device__ __forceinline__ void operator()(const v4i32 (&acc)[2][2][4][2], const Unit& u, int wr, int wc, int fr, int fq) const {
        const int row0 = u.om * BM + wr * 64 + fr, col0 = u.on * BM + wc * 32 + 8 * fq;
        f32x4 cv[2][2];
#pragma unroll
        for (int bj = 0; bj < 2; ++bj) { cv[bj][0] = *(const f32x4*)(cs + col0 + bj * HALF); cv[bj][1] = *(const f32x4*)(cs + col0 + bj * HALF + 4); }
#pragma unroll
        for (int ai = 0; ai < 2; ++ai)
#pragma unroll
            for (int m = 0; m < 4; ++m) { const int r = row0 + ai * HALF + m * 16; const float hs = rs[r]; bf16_t* rowp = O + (size_t)r * ldc + col0;
#pragma unroll
                for (int bj = 0; bj < 2; ++bj) { const f32x4 v0 = __builtin_convertvector(acc[ai][bj][m][0], f32x4) * (cv[bj][0] * hs), v1 = __builtin_convertvector(acc[ai][bj][m][1], f32x4) * (cv[bj][1] * hs);
                    u32x4 w; w.x = cvt_pk_bf16(v0[0], v0[1]); w.y = cvt_pk_bf16(v0[2], v0[3]); w.z = cvt_pk_bf16(v1[0], v1[1]); w.w = cvt_pk_bf16(v1[2], v1[3]);
                    *(u32x4*)(rowp + bj * HALF) = w; } }
    }
};

template <class Epi, class Sched, bool ALIGN_EPI = false, bool SP2 = false, int MODE = 0  >
__device__ __forceinline__ void gemm_phase(PG8_LAS unsigned char* lds, const Gemm g, const Sched& S, const Epi& E, const int wave_idx  ) {
    int lane_; asm volatile("v_mbcnt_lo_u32_b32 %0, -1, 0\n\tv_mbcnt_hi_u32_b32 %0, -1, %0" : "=v"(lane_));
    const int wid = wave_idx, lane = lane_, tid = wid * 64 + lane, wr = wid >> 2, wc = wid & 3, fr = lane & 15, fq = lane >> 4;
    const int K = g.K, KB = MODE ? K : 2 * K  , PB = g.pitch ? g.pitch : KB  , nt = KB / (BK * 2);
    unsigned voffA, voffB;
    { int R, C; stage_rc(tid * 16, R, C); const int Rb = Epi::PERM ? ((R & ~31) + perm32(R & 31)) : R;
        voffA = (unsigned)(R * PB + C * 2); voffB = (unsigned)(Rb * PB + C * 2); }
    const size_t rstep = (size_t)64 * PB;
    const size_t kstep = (size_t)(BK * 2);
    const size_t hstep = (size_t)HALF * PB;
    const size_t tstep = 2 * hstep;
    const unsigned ldsw = (unsigned)wid * 1024u; const unsigned ldsb = (unsigned)__builtin_amdgcn_readfirstlane((int)((unsigned)(size_t)lds + ldsw));
    const int aoff = lds_byte(wr * 64 + fr, fq * 8), boff = lds_byte(wc * 32 + fr, fq * 8);
#define PG8_SA(b, h) (((b) * 2 + (h)) * HTB)
#define PG8_SB(b, h) ((4 + (b) * 2 + (h)) * HTB)
#define PG8_STAGE(bufoff, gbase, voff) do { _Pragma("unroll") for (int _i = 0; _i < 2; ++_i) glds16s((const char*)(gbase) + _i * rstep, (voff), ldsb + (unsigned)((bufoff) + _i * 8192)); } while (0)
#define PG8_LDA(dst, b, h) do { if constexpr (MODE == 1) { _Pragma("unroll") for (int m = 0; m < 4; ++m) { const v4i32 l_ = *(const PG8_LAS v4i32*)(lds + PG8_SA(b, h) + aoff + m * 2048), h_ = *(const PG8_LAS v4i32*)(lds + PG8_SA(b, h) + aoff + m * 2048 + 1024); dst##8[m] = __builtin_shufflevector(l_, h_, 0, 1, 2, 3, 4, 5, 6, 7); } } \
        else { _Pragma("unroll") for (int m = 0; m < 4; ++m) _Pragma("unroll") for (int k = 0; k < 2; ++k) dst[m][k] = *(const PG8_LAS bf16x8*)(lds + PG8_SA(b, h) + aoff + m * 2048 + k * 1024); } } while (0)
#define PG8_LDB(dst, b, h) do { if constexpr (MODE == 1) { _Pragma("unroll") for (int n = 0; n < 2; ++n) { const v4i32 l_ = *(const PG8_LAS v4i32*)(lds + PG8_SB(b, h) + boff + n * 2048), h_ = *(const PG8_LAS v4i32*)(lds + PG8_SB(b, h) + boff + n * 2048 + 1024); dst##8[n] = __builtin_shufflevector(l_, h_, 0, 1, 2, 3, 4, 5, 6, 7); } } \
        else { _Pragma("unroll") for (int n = 0; n < 2; ++n) _Pragma("unroll") for (int k = 0; k < 2; ++k) dst[n][k] = *(const PG8_LAS bf16x8*)(lds + PG8_SB(b, h) + boff + n * 2048 + k * 1024); } } while (0)
#define PG8_MMA(ai, bj, At, Bt) do { __builtin_amdgcn_s_setprio(1); _Pragma("unroll") for (int m = 0; m < 4; ++m) _Pragma("unroll") for (int n = 0; n < 2; ++n) { \
        if constexpr (MODE == 1) { acc[ai][bj][m][n] = __builtin_amdgcn_mfma_scale_f32_16x16x128_f8f6f4(Bt##8[n], At##8[m], acc[ai][bj][m][n], 0, 0, 0, 0, 0, 0); }     \
        else if constexpr (MODE == 2) { _Pragma("unroll") for (int k = 0; k < 2; ++k) acc[ai][bj][m][n] = __builtin_amdgcn_mfma_i32_16x16x64_i8(__builtin_bit_cast(v4i32, Bt[n][k]), __builtin_bit_cast(v4i32, At[m][k]), acc[ai][bj][m][n], 0, 0, 0); } \
        else { _Pragma("unroll") for (int k = 0; k < 2; ++k) acc[ai][bj][m][n] = __builtin_amdgcn_mfma_f32_16x16x32_bf16(Bt[n][k], At[m][k], acc[ai][bj][m][n], 0, 0, 0); } } __builtin_amdgcn_s_setprio(0); } while (0)
#define PG8_WAIT_V(n) asm volatile("s_waitcnt vmcnt(" #n ")" ::: "memory")
#define PG8_WAIT_L(n) asm volatile("s_waitcnt lgkmcnt(" #n ")" ::: "memory")
#define PG8_BAR __builtin_amdgcn_s_barrier()
#define PG8_SCHED __builtin_amdgcn_sched_barrier(0)
    Unit cur, nxt; int ui = 0;
    if (!S.next(0, cur)) return;
    typedef typename AccSel<MODE>::T AccT; AccT acc[2][2][4][2];
#pragma unroll
    for (int a = 0; a < 2; ++a)
#pragma unroll
        for (int b = 0; b < 2; ++b)
#pragma unroll
            for (int m = 0; m < 4; ++m)
#pragma unroll
                for (int n = 0; n < 2; ++n) acc[a][b][m][n] = AccT{};
    bf16x8 At[4][2], B0[2][2], B1[2][2]; v8i32 At8[4], B08[2], B18[2];
    const char* cA = (const char*)g.A + (size_t)cur.pm * tstep + cur.koff; const char* cB = (const char*)g.Bt + (size_t)cur.pn * tstep + cur.koff;
    S.a_ready(cur);
    if constexpr (SP2) {
        PG8_STAGE(PG8_SB(0, 0), cB, voffB); PG8_STAGE(PG8_SB(0, 1), cB + hstep, voffB); PG8_STAGE(PG8_SA(0, 0), cA, voffA); PG8_STAGE(PG8_SA(0, 1), cA + hstep, voffA);
        if (wr == 1) PG8_BAR;
        PG8_WAIT_V(2); PG8_BAR;
        PG8_STAGE(PG8_SB(1, 0), cB + kstep, voffB); PG8_STAGE(PG8_SA(1, 0), cA + kstep, voffA); PG8_STAGE(PG8_SB(1, 1), cB + hstep + kstep, voffB);
        PG8_WAIT_V(6); PG8_BAR;
    } else {
        PG8_STAGE(PG8_SB(0, 0), cB, voffB); PG8_STAGE(PG8_SA(0, 0), cA, voffA); PG8_STAGE(PG8_SB(0, 1), cB + hstep, voffB); PG8_STAGE(PG8_SA(0, 1), cA + hstep, voffA);
        if (wr == 1) PG8_BAR;
        PG8_WAIT_V(4); PG8_BAR;
        PG8_STAGE(PG8_SB(1, 0), cB + kstep, voffB); PG8_STAGE(PG8_SA(1, 0), cA + kstep, voffA); PG8_STAGE(PG8_SB(1, 1), cB + hstep + kstep, voffB);
        PG8_WAIT_V(6); PG8_BAR;
    }
    for (;;) {
        const bool has_next = S.next(ui + 1, nxt);
        const char* nA = has_next ? (const char*)g.A + (size_t)nxt.pm * tstep + nxt.koff : cA; const char* nB = has_next ? (const char*)g.Bt + (size_t)nxt.pn * tstep + nxt.koff : cB;
        for (int t = 0; t < nt; t += 2) {
            const bool last = (t == nt - 2);
            const char* a1 = cA + (size_t)(t + 1) * kstep;
            const char* a2 = last ? nA : cA + (size_t)(t + 2) * kstep; const char* b2 = last ? nB : cB + (size_t)(t + 2) * kstep;
            const char* a3 = a2 + kstep; const char* b3 = b2 + kstep;
            if (last && has_next) S.a_ready(nxt);
            if constexpr (SP2) {
            PG8_LDB(B0, 0, 0); PG8_LDB(B1, 0, 1); PG8_SCHED; PG8_LDA(At, 0, 0); PG8_STAGE(PG8_SA(1, 1), a1 + hstep, voffA);
            PG8_WAIT_V(8); PG8_WAIT_L(0); PG8_BAR; PG8_MMA(0, 0, At, B0); PG8_MMA(0, 1, At, B1); PG8_BAR; PG8_SCHED;
            PG8_LDA(At, 0, 1); PG8_STAGE(PG8_SB(0, 0), b2, voffB); PG8_STAGE(PG8_SB(0, 1), b2 + hstep, voffB); PG8_STAGE(PG8_SA(0, 0), a2, voffA);
            PG8_WAIT_V(8); PG8_WAIT_L(0); PG8_BAR; PG8_MMA(1, 0, At, B0); PG8_MMA(1, 1, At, B1); PG8_BAR; PG8_SCHED;
            PG8_LDB(B0, 1, 0); PG8_LDB(B1, 1, 1); PG8_SCHED; PG8_LDA(At, 1, 0); PG8_STAGE(PG8_SA(0, 1), a2 + hstep, voffA);
            PG8_WAIT_V(8); PG8_WAIT_L(0); PG8_BAR; PG8_MMA(0, 0, At, B0); PG8_MMA(0, 1, At, B1); PG8_BAR; PG8_SCHED;
            PG8_LDA(At, 1, 1); PG8_STAGE(PG8_SB(1, 0), b3, voffB); PG8_STAGE(PG8_SB(1, 1), b3 + hstep, voffB); PG8_STAGE(PG8_SA(1, 0), a3, voffA);
            PG8_WAIT_V(8); PG8_WAIT_L(0); PG8_BAR; PG8_MMA(1, 0, At, B0); PG8_MMA(1, 1, At, B1); PG8_BAR; PG8_SCHED;
            } else {
            PG8_LDB(B0, 0, 0); PG8_SCHED; PG8_LDA(At, 0, 0); PG8_STAGE(PG8_SA(1, 1), a1 + hstep, voffA);
            PG8_WAIT_L(8); PG8_BAR; PG8_WAIT_L(0); PG8_MMA(0, 0, At, B0); PG8_BAR; PG8_SCHED;
            PG8_LDB(B1, 0, 1); PG8_STAGE(PG8_SB(0, 0), b2, voffB);
            PG8_BAR; PG8_WAIT_L(0); PG8_MMA(0, 1, At, B1); PG8_BAR;
            PG8_LDA(At, 0, 1); PG8_STAGE(PG8_SA(0, 0), a2, voffA);
            PG8_BAR; PG8_WAIT_L(0); PG8_MMA(1, 0, At, B0); PG8_BAR; PG8_SCHED;
            PG8_STAGE(PG8_SB(0, 1), b2 + hstep, voffB);
            PG8_WAIT_V(6); PG8_BAR; PG8_MMA(1, 1, At, B1); PG8_BAR;
            PG8_LDB(B0, 1, 0); PG8_SCHED; PG8_LDA(At, 1, 0); PG8_STAGE(PG8_SA(0, 1), a2 + hstep, voffA);
            PG8_WAIT_L(8); PG8_BAR; PG8_WAIT_L(0); PG8_MMA(0, 0, At, B0); PG8_BAR; PG8_SCHED;
            PG8_LDB(B1, 1, 1); PG8_STAGE(PG8_SB(1, 0), b3, voffB);
            PG8_BAR; PG8_WAIT_L(0); PG8_MMA(0, 1, At, B1); PG8_BAR;
            PG8_LDA(At, 1, 1); PG8_STAGE(PG8_SA(1, 0), a3, voffA);
            PG8_BAR; PG8_WAIT_L(0); PG8_MMA(1, 0, At, B0); PG8_BAR; PG8_SCHED;
            PG8_STAGE(PG8_SB(1, 1), b3 + hstep, voffB);
            PG8_WAIT_V(6); PG8_BAR; PG8_MMA(1, 1, At, B1); PG8_BAR;
            }
        }
        if constexpr (ALIGN_EPI) { if (wr == 0) PG8_BAR; }
        if constexpr (!Epi::AFTER_DRAIN) { E(acc, cur, wr, wc, fr, fq); S.done(cur); }
        if (!has_next) break;
#pragma unroll
        for (int a = 0; a < 2; ++a)
#pragma unroll
            for (int b = 0; b < 2; ++b)
#pragma unroll
                for (int m = 0; m < 4; ++m)
#pragma unroll
                    for (int n = 0; n < 2; ++n) acc[a][b][m][n] = AccT{};
        cur = nxt; cA = nA; cB = nB; ++ui;
        if constexpr (ALIGN_EPI) { if (wr == 1) PG8_BAR; }
    }
    PG8_WAIT_V(0);
    if constexpr (!ALIGN_EPI) { if (wr == 0) PG8_BAR; }
    PG8_BAR;
    if constexpr (Epi::AFTER_DRAIN) { E.fused(acc, cur, wr, wc, fr, fq, lds, wid, lane); S.done(cur); }
#undef PG8_SA
#undef PG8_SB
#undef PG8_STAGE
#undef PG8_LDA
#undef PG8_LDB
#undef PG8_MMA
#undef PG8_WAIT_V
#undef PG8_WAIT_L
#undef PG8_BAR
#undef PG8_SCHED
}
}

#ifndef MK_MOE_XIL
#define MK_MOE_XIL 1
#endif

#ifndef MK_WGM_QK
#define MK_WGM_QK 4
#endif
#ifndef MK_WGM_VT
#define MK_WGM_VT 4
#endif
#ifndef MK_WGM_N8
#define MK_WGM_N8 4
#endif
#ifndef MK_WGM_FI
#define MK_WGM_FI 4
#endif

#ifndef MK_WGM_MOE
#define MK_WGM_MOE 4
#endif

#ifndef MK_QKV0_I8
#define MK_QKV0_I8 1
#endif
#ifndef MK_QKV1_I8
#define MK_QKV1_I8 1
#endif

constexpr int NWAVES = 8;
constexpr int DM = 2048, NB = 8, SEQ = 2048, M = NB * SEQ, NH = 16, HD = 128, DFF = 5632, NE = 8, DFE = 7168, NQKV = 3 * DM, NMOD = 6 * DM;
constexpr int ECAP = 16384;
constexpr int MOE_TILES = 136;
constexpr float EPS = 1e-6f;
constexpr float ATT_SCALE = 0.08838834764831845f;
constexpr float LOG2E = 1.4426950408889634f;

constexpr size_t MiB = 1u << 20;
constexpr size_t WS_CTL = 0, CTL_ZERO_BYTES = 1 * MiB;
constexpr size_t WS_MOD = 1 * MiB;
constexpr size_t WS_KMEAN = 2 * MiB;
constexpr size_t WS_POSC = 3 * MiB;
constexpr size_t WS_GWC = 4 * MiB;
constexpr size_t WS_HSCALE = 5 * MiB;
constexpr size_t WS_WSCFI = 6 * MiB;
constexpr size_t WS_WSCQKV = 7 * MiB;
constexpr size_t WS_WQKV = 8 * MiB;
constexpr size_t WS_WO = 56 * MiB;
constexpr size_t WS_WFI = 72 * MiB;
constexpr size_t WS_WFO = 116 * MiB;
constexpr size_t WS_WMI = 138 * MiB;
constexpr size_t WS_WMO = 586 * MiB;
constexpr size_t WS_HB = 810 * MiB;
constexpr size_t WS_QKV = 874 * MiB;
constexpr size_t WS_AO = 1066 * MiB;
constexpr size_t WS_HID = 1130 * MiB;
constexpr size_t WS_HSORT = 1306 * MiB;
constexpr size_t WS_HID2 = 1818 * MiB;
constexpr size_t WS_YP = 2294 * MiB;
constexpr size_t WS_YT = 2430 * MiB;
constexpr size_t WS_XB = 2494 * MiB;
constexpr size_t WS_END = 2558 * MiB;
static_assert(WS_WQKV + 2ull * NQKV * DM * 2 <= WS_WO && WS_WO + 2ull * DM * DM * 2 <= WS_WFI && WS_WFI + 2ull * DFF * DM * 2 <= WS_WFO && WS_WFO + (size_t)DM * DFF * 2 <= WS_WMI, "ws map 1");
static_assert(WS_WMI + 8ull * 2 * DFE * DM * 2 <= WS_WMO && WS_WMO + 8ull * DM * DFE * 2 <= WS_HB && WS_HB + (size_t)M * DM * 2 <= WS_QKV && WS_QKV + (size_t)M * NQKV * 2 <= WS_AO, "ws map 2");
static_assert(WS_AO + (size_t)M * DM * 2 <= WS_HID && WS_HID + (size_t)M * DFF * 2 <= WS_HSORT && WS_HSORT + 8ull * ECAP * DM * 2 <= WS_HID2 && WS_HID2 + (size_t)MOE_TILES * 256 * DFE * 2 <= WS_YP && WS_YP + (size_t)MOE_TILES * 256 * DM * 2 <= WS_YT && WS_YT + 4ull * 8 * 256 * DM * 4 <= WS_XB && WS_XB + (size_t)M * DM * 2 <= WS_END, "ws map 3");
constexpr int CW_TMO = 0;
constexpr int CW_CNT = 1024;
constexpr int CW_BAR = 4096;

constexpr int RING_OFF = 0, RING_BYTES = 131072;
constexpr int LDSCTL_OFF = 141312  , MISC_OFF = LDSCTL_OFF + 320;
constexpr int LDS_BYTES = 147456;

#define LAS __attribute__((address_space(3)))
typedef unsigned short bf16;
typedef float f32x4 __attribute__((ext_vector_type(4)));
typedef unsigned v4u __attribute__((ext_vector_type(4)));
typedef unsigned v2u __attribute__((ext_vector_type(2)));
#define LDS_WAIT() asm volatile("s_waitcnt lgkmcnt(0)" ::: "memory")
__device__ __forceinline__ unsigned f2bf(float f) { unsigned u = __builtin_bit_cast(unsigned, f); return (u + 0x7fffu + ((u >> 16) & 1u)) >> 16; }
__device__ __forceinline__ unsigned pk2(float lo, float hi) { return f2bf(lo) | (f2bf(hi) << 16); }
__device__ __forceinline__ float bflo(unsigned u) { return __builtin_bit_cast(float, u << 16); }
__device__ __forceinline__ float bfhi(unsigned u) { return __builtin_bit_cast(float, u & 0xffff0000u); }
__device__ __forceinline__ float rdlane(float v, int l) { return __builtin_bit_cast(float, __builtin_amdgcn_readlane(__builtin_bit_cast(int, v), l)); }
template <int CTRL> __device__ __forceinline__ float dppf(float v) { return __builtin_bit_cast(float, __builtin_amdgcn_update_dpp(0, __builtin_bit_cast(int, v), CTRL, 0xF, 0xF, true)); }
__device__ __forceinline__ float wave_sum(float v) {
    v += dppf<0xB1>(v); v += dppf<0x4E>(v); v += dppf<0x141>(v); v += dppf<0x140>(v);
    return (rdlane(v, 0) + rdlane(v, 16)) + (rdlane(v, 32) + rdlane(v, 48));
}
__device__ __forceinline__ float wave_max(float v) {
    v = fmaxf(v, dppf<0xB1>(v)); v = fmaxf(v, dppf<0x4E>(v)); v = fmaxf(v, dppf<0x141>(v)); v = fmaxf(v, dppf<0x140>(v));
    return fmaxf(fmaxf(rdlane(v, 0), rdlane(v, 16)), fmaxf(rdlane(v, 32), rdlane(v, 48)));
}

#define XB_TMO      128
#define XB_XCNT(j)  (256  + 64 * (j))
#define XB_XSUB(j)  (1280 + 64 * (j))
#define XB_XGEN(j)  (2304 + 64 * (j))
#define XB_TOP      3328
#define XB_TOPGEN   3392
#define XCD_BAR_WORDS 3456
#define XB_SPIN_CAP (1u << 20)
__device__ __forceinline__ unsigned xb_ld(unsigned* p)              { return __hip_atomic_load(p, __ATOMIC_RELAXED, __HIP_MEMORY_SCOPE_AGENT); }
__device__ __forceinline__ unsigned xb_add(unsigned* p, unsigned v) { return __hip_atomic_fetch_add(p, v, __ATOMIC_RELAXED, __HIP_MEMORY_SCOPE_AGENT); }
__device__ __forceinline__ unsigned xb_xcc_id() { return (unsigned)__builtin_amdgcn_s_getreg((3 << 11) | 20) & 0xFu; }
#define XB_SPIN(cond, bar) do { unsigned _sp = 0; while (cond) { __builtin_amdgcn_s_sleep(1); \
    if ((++_sp & 255u) == 0u) { if (xb_ld(&(bar)[XB_TMO])) break; if (_sp > XB_SPIN_CAP) { atomicAdd(&(bar)[XB_TMO], 1u); break; } } } } while (0)
struct XcdBarrier { unsigned* bar; unsigned x; volatile LAS unsigned* st; int wave; };
__device__ __forceinline__ int lane_id();
__device__ __forceinline__ bool xb_leader(int wave) { return wave == 0 && lane_id() == 0; }
__device__ __forceinline__ XcdBarrier xcd_barrier_post(unsigned* bar, volatile LAS unsigned* st, int wave) {
    XcdBarrier b; b.bar = bar; b.x = xb_xcc_id(); b.st = st; b.wave = wave;
    if (xb_leader(wave)) (void)xb_add(&bar[XB_XCNT(b.x)], 1u);
    return b;
}
__device__ __forceinline__ void xcd_barrier_complete(unsigned* bar, unsigned x, unsigned& nloc, unsigned& nx) {
    const unsigned G = gridDim.x * gridDim.y * gridDim.z;
    unsigned sum, cnt, mine, sp = 0u;
    for (;;) {
        sum = 0u; cnt = 0u; mine = 0u;
#pragma unroll
        for (unsigned j = 0; j < 16; ++j) { const unsigned c = xb_ld(&bar[XB_XCNT(j)]); sum += c; cnt += (c > 0u) ? 1u : 0u; mine = (j == x) ? c : mine; }
        if (sum == G) break;
        __builtin_amdgcn_s_sleep(1);
        if ((++sp & 255u) == 0u) { if (xb_ld(&bar[XB_TMO])) break; if (sp > XB_SPIN_CAP) { atomicAdd(&bar[XB_TMO], 1u); break; } }
    }
    nloc = mine > 0u ? mine : 1u; nx = cnt > 0u ? cnt : 1u;
}
__device__ __forceinline__ void xcd_barrier(const XcdBarrier& b) {
    asm volatile("s_waitcnt vmcnt(0)" ::: "memory");
    __syncthreads();
    if (xb_leader(b.wave)) {
        unsigned* bar = b.bar;
        __builtin_amdgcn_s_waitcnt(0);
        unsigned nloc = b.st[0], nx = b.st[1];
        if (nloc == 0u) { xcd_barrier_complete(bar, b.x, nloc, nx); b.st[0] = nloc; b.st[1] = nx; }
        const unsigned old = xb_add(&bar[XB_XSUB(b.x)], 1u);
        const unsigned gen = old / nloc;
        if (old + 1u == (gen + 1u) * nloc) {
            __builtin_amdgcn_fence(__ATOMIC_RELEASE, "agent");
            asm volatile("s_waitcnt vmcnt(0)" ::: "memory");
            const unsigned og = xb_add(&bar[XB_TOP], 1u);
            const unsigned tg = og / nx;
            if (og + 1u == (tg + 1u) * nx) xb_add(&bar[XB_TOPGEN], 1u);
            else XB_SPIN(xb_ld(&bar[XB_TOPGEN]) == tg, bar);
            __builtin_amdgcn_fence(__ATOMIC_ACQUIRE, "agent");
            xb_add(&bar[XB_XGEN(b.x)], 1u);
            asm volatile("s_waitcnt vmcnt(0)" ::: "memory");
        } else {
            XB_SPIN(xb_ld(&bar[XB_XGEN(b.x)]) == gen, bar);
            __builtin_amdgcn_fence(__ATOMIC_ACQUIRE, "agent");
            asm volatile("s_waitcnt vmcnt(0)" ::: "memory");
        }
    }
    __syncthreads();
}

struct Frame {
    unsigned char* lds;
    unsigned* ctl;
    int tid, lane, wave, wave0, vcu, G;
    const float *x, *c, *w_ada, *b_ada, *attn_norm, *ffn_norm, *w_qkv, *w_o, *qn_q, *qn_k, *ffn_w_in, *ffn_w_out, *router_w, *moe_w_in, *moe_w_out;
    float* out;
    float *MOD, *KMEAN, *GWC, *HSCALE, *WSCFI, *WSCQKV, *WSCQKV0, *WSCO, *YT; int* POSC;
    bf16 *WQKV, *WO, *WFI, *WFO, *WMI, *WMO, *HB, *QK, *VT, *AO, *XB, *HID, *HSORT, *HID2, *YP;
};

__device__ __forceinline__ void phase_ada(Frame& F) {
    float* cs = (float*)(F.lds);
    float* red = (float*)(F.lds + 65536);
    for (int i = F.tid; i < NB * DM; i += NWAVES * 64) { const int b = i / DM, k = i % DM; cs[k * 8 + b] = F.c[i]; }
    __syncthreads();
    const int cq = F.tid % 24, kg = F.tid / 24;
    for (int u = blockIdx.x; u < 256; u += F.G) {
        const int l = u >> 7, col0 = (u & 127) * 96;
        f32x4 acc[8];
#pragma unroll
        for (int b = 0; b < 8; ++b) acc[b] = (f32x4){0.f, 0.f, 0.f, 0.f};
        if (kg < 21) {
            const float* wp = F.w_ada + (size_t)l * DM * NMOD + col0 + cq * 4;
#pragma unroll 4
            for (int k = kg; k < DM; k += 21) {
                const f32x4 w = *(const f32x4*)(wp + (size_t)k * NMOD);
                const f32x4 c0 = *(const f32x4*)(cs + k * 8), c1 = *(const f32x4*)(cs + k * 8 + 4);
                acc[0] += w * c0[0]; acc[1] += w * c0[1]; acc[2] += w * c0[2]; acc[3] += w * c0[3];
                acc[4] += w * c1[0]; acc[5] += w * c1[1]; acc[6] += w * c1[2]; acc[7] += w * c1[3];
            }
#pragma unroll
            for (int b = 0; b < 8; ++b) *(f32x4*)(red + (kg * 8 + b) * 96 + cq * 4) = acc[b];
        }
        __syncthreads();
        for (int o = F.tid; o < 8 * 96; o += NWAVES * 64) { const int b = o / 96, cc = o % 96; float s = F.b_ada[l * NMOD + col0 + cc];
            for (int g = 0; g < 21; ++g) s += red[(g * 8 + b) * 96 + cc];
            F.MOD[(size_t)(l * 8 + b) * NMOD + col0 + cc] = s; }
        __syncthreads();
    }
}

__device__ __forceinline__ void transpose_item(const float* W, int K, int N, bf16* WT, int ilv, float* scr, int item, int lane) {
    const int nblk = N / 32, kb = item / nblk, nb = item % nblk, k0 = 64 * kb, n0 = 32 * nb;
    int row0 = n0;
    if (ilv) { const int up = n0 >= ilv, j0 = n0 - (up ? ilv : 0); row0 = (j0 >> 7) * 256 + (up ? 128 : 0) + (j0 & 127); }
#pragma unroll 16
    for (int i = 0; i < 32; ++i) { const int kk = 2 * i + (lane >> 5); scr[kk * 33 + (lane & 31)] = __builtin_nontemporal_load(W + (size_t)(k0 + kk) * N + n0 + (lane & 31)); }
    LDS_WAIT(); asm volatile("" ::: "memory");
    const int c = lane & 7;
#pragma unroll
    for (int j = 0; j < 4; ++j) { const int n = (lane >> 3) + 8 * j; const float* s = scr + (8 * c) * 33 + n;
        v4u o; o.x = pk2(s[0 * 33], s[1 * 33]); o.y = pk2(s[2 * 33], s[3 * 33]); o.z = pk2(s[4 * 33], s[5 * 33]); o.w = pk2(s[6 * 33], s[7 * 33]);
        *(v4u*)(WT + (size_t)(row0 + n) * K + k0 + 8 * c) = o; }
    LDS_WAIT(); asm volatile("" ::: "memory");
}
__device__ __forceinline__ int ilv_row(int n, int ilv) { if (!ilv) return n; const int up = n >= ilv, j = n - (up ? ilv : 0); return (j >> 7) * 256 + (up ? 128 : 0) + (j & 127); }
__device__ __forceinline__ void colscale_unit(Frame& F, const float* W, int K, int N, int ilv, float* scale, int unit) {
    float* red = (float*)F.lds;
    const int cq = F.tid & 15, kg = F.tid >> 4, col0 = unit * 64 + cq * 4;
    f32x4 mx = {0.f, 0.f, 0.f, 0.f};
#pragma unroll 4
    for (int k = kg; k < K; k += 32) { const f32x4 w = *(const f32x4*)(W + (size_t)k * N + col0); mx[0] = fmaxf(mx[0], fabsf(w[0])); mx[1] = fmaxf(mx[1], fabsf(w[1])); mx[2] = fmaxf(mx[2], fabsf(w[2])); mx[3] = fmaxf(mx[3], fabsf(w[3])); }
    *(f32x4*)(red + kg * 64 + cq * 4) = mx;
    __syncthreads();
    if (F.tid < 64) { float m = 0.f;
#pragma unroll
        for (int g = 0; g < 32; ++g) m = fmaxf(m, red[g * 64 + F.tid]);
        scale[ilv_row(unit * 64 + F.tid, ilv)] = fmaxf(m, 1e-30f) * (1.0f / 127.0f); }
    __syncthreads();
}
__device__ __forceinline__ void phase_colscale(Frame& F) {
    constexpr int U_FI = 2 * DFF / 64, U_Q = NQKV / 64, U_Q0 = MK_QKV0_I8 ? NQKV / 64 : 0;
    for (int u = blockIdx.x; u < U_FI + U_Q + U_Q0; u += F.G) {
        if (u < U_FI) colscale_unit(F, F.ffn_w_in, DM, 2 * DFF, DFF, F.WSCFI, u);
        else if (u < U_FI + U_Q) colscale_unit(F, F.w_qkv + (size_t)DM * NQKV, DM, NQKV, 0, F.WSCQKV, u - U_FI);
        else colscale_unit(F, F.w_qkv, DM, NQKV, 0, F.WSCQKV0, u - U_FI - U_Q);
    }
}
__device__ __forceinline__ unsigned pack4_i8_nc(float a, float b, float c, float d) {
    const float MG = 12582912.0f;
    const unsigned ua = __builtin_bit_cast(unsigned, a + MG), ub = __builtin_bit_cast(unsigned, b + MG), uc = __builtin_bit_cast(unsigned, c + MG), ud = __builtin_bit_cast(unsigned, d + MG);
    return __builtin_amdgcn_perm(ub, ua, 0x0c0c0400u) | __builtin_amdgcn_perm(ud, uc, 0x04000c0cu); }
__device__ __forceinline__ unsigned pack4_i8(float a, float b, float c, float d) {
    return pack4_i8_nc(__builtin_amdgcn_fmed3f(a, -127.f, 127.f), __builtin_amdgcn_fmed3f(b, -127.f, 127.f), __builtin_amdgcn_fmed3f(c, -127.f, 127.f), __builtin_amdgcn_fmed3f(d, -127.f, 127.f)); }
__device__ __forceinline__ void transpose_item_i8(const float* W, int K, int N, unsigned char* WT, int ilv, const float* scale, float* scr, int item, int lane) {
    const int nblk = N / 32, kb = item / nblk, nb = item % nblk, k0 = 128 * kb, n0 = 32 * nb;
    const int row0 = ilv_row(n0, ilv);
#pragma unroll 16
    for (int i = 0; i < 64; ++i) { const int kk = 2 * i + (lane >> 5); scr[kk * 33 + (lane & 31)] = __builtin_nontemporal_load(W + (size_t)(k0 + kk) * N + n0 + (lane & 31)); }
    LDS_WAIT(); asm volatile("" ::: "memory");
    const int c = lane & 7;
#pragma unroll
    for (int j = 0; j < 4; ++j) { const int n = (lane >> 3) + 8 * j; const float* s = scr + (16 * c) * 33 + n; const float inv = 1.0f / scale[row0 + n];
        v4u o; o.x = pack4_i8(s[0 * 33] * inv, s[1 * 33] * inv, s[2 * 33] * inv, s[3 * 33] * inv); o.y = pack4_i8(s[4 * 33] * inv, s[5 * 33] * inv, s[6 * 33] * inv, s[7 * 33] * inv);
        o.z = pack4_i8(s[8 * 33] * inv, s[9 * 33] * inv, s[10 * 33] * inv, s[11 * 33] * inv); o.w = pack4_i8(s[12 * 33] * inv, s[13 * 33] * inv, s[14 * 33] * inv, s[15 * 33] * inv);
        *(v4u*)(WT + (size_t)(row0 + n) * K + k0 + 16 * c) = o; }
    LDS_WAIT(); asm volatile("" ::: "memory");
}
__device__ __forceinline__ void transpose_item_f8(const float* W, int K, int N, unsigned char* WT, int ilv, float mult, float* scr, int item, int lane) {
    const int nblk = N / 32, kb = item / nblk, nb = item % nblk, k0 = 128 * kb, n0 = 32 * nb;
    int row0 = n0;
    if (ilv) { const int up = n0 >= ilv, j0 = n0 - (up ? ilv : 0); row0 = (j0 >> 7) * 256 + (up ? 128 : 0) + (j0 & 127); }
#pragma unroll 16
    for (int i = 0; i < 64; ++i) { const int kk = 2 * i + (lane >> 5); scr[kk * 33 + (lane & 31)] = __builtin_nontemporal_load(W + (size_t)(k0 + kk) * N + n0 + (lane & 31)); }
    LDS_WAIT(); asm volatile("" ::: "memory");
    const int c = lane & 7;
#pragma unroll
    for (int j = 0; j < 4; ++j) { const int n = (lane >> 3) + 8 * j; const float* s = scr + (16 * c) * 33 + n;
        v4u o; o.x = pg8::cvt4_fp8(s[0 * 33] * mult, s[1 * 33] * mult, s[2 * 33] * mult, s[3 * 33] * mult); o.y = pg8::cvt4_fp8(s[4 * 33] * mult, s[5 * 33] * mult, s[6 * 33] * mult, s[7 * 33] * mult);
        o.z = pg8::cvt4_fp8(s[8 * 33] * mult, s[9 * 33] * mult, s[10 * 33] * mult, s[11 * 33] * mult); o.w = pg8::cvt4_fp8(s[12 * 33] * mult, s[13 * 33] * mult, s[14 * 33] * mult, s[15 * 33] * mult);
        *(v4u*)(WT + (size_t)(row0 + n) * K + k0 + 16 * c) = o; }
    LDS_WAIT(); asm volatile("" ::: "memory");
}
__device__ __forceinline__ void i8_slab(Frame& F, const float* W, int N, unsigned char* WT, int ilv, float* scale, int slab) {
    constexpr int PITCH = 4112;
    unsigned char* T = F.lds; float* cmx = (float*)(F.lds + 32 * PITCH);
    const int lane = F.lane, w = F.wave, c4 = lane & 7, kr = lane >> 3, n0 = 32 * slab, row0 = ilv_row(n0, ilv);
    { const float* src = W + (size_t)(256 * w + 32 * kr) * N + n0 + 4 * c4;
      f32x4 v[32];
#pragma unroll
      for (int i = 0; i < 32; ++i) v[i] = __builtin_nontemporal_load((const f32x4*)(src + (size_t)i * N));
      f32x4 mx = {0.f, 0.f, 0.f, 0.f};
#pragma unroll
      for (int i = 0; i < 32; ++i) { mx[0] = fmaxf(mx[0], fabsf(v[i][0])); mx[1] = fmaxf(mx[1], fabsf(v[i][1])); mx[2] = fmaxf(mx[2], fabsf(v[i][2])); mx[3] = fmaxf(mx[3], fabsf(v[i][3])); }
#pragma unroll
      for (int e = 0; e < 4; ++e) { unsigned char* dst = T + (8 * e + c4) * PITCH + 2 * (256 * w + 32 * kr);
#pragma unroll
          for (int qd = 0; qd < 4; ++qd) { v4u o; o.x = pk2(v[8 * qd + 0][e], v[8 * qd + 1][e]); o.y = pk2(v[8 * qd + 2][e], v[8 * qd + 3][e]); o.z = pk2(v[8 * qd + 4][e], v[8 * qd + 5][e]); o.w = pk2(v[8 * qd + 6][e], v[8 * qd + 7][e]);
              *(v4u*)(dst + 16 * qd) = o; } }
#pragma unroll
      for (int e = 0; e < 4; ++e) { mx[e] = fmaxf(mx[e], __shfl_xor(mx[e], 8)); mx[e] = fmaxf(mx[e], __shfl_xor(mx[e], 16)); mx[e] = fmaxf(mx[e], __shfl_xor(mx[e], 32)); }
      if (kr == 0) *(f32x4*)(cmx + w * 32 + 4 * c4) = mx; }
    __syncthreads();
    { const int n = F.tid >> 4, kc = F.tid & 15;
      float m = 0.f;
#pragma unroll
      for (int ww = 0; ww < 8; ++ww) m = fmaxf(m, cmx[ww * 32 + n]);
      const float sc = fmaxf(m, 1e-30f) * (1.0f / 127.0f), inv = 1.0f / sc;
      if (kc == 0) scale[row0 + n] = sc;
      const unsigned char* srow = T + (8 * (n & 3) + (n >> 2)) * PITCH + 32 * kc; unsigned char* drow = WT + (size_t)(row0 + n) * DM + 16 * kc;
#pragma unroll
      for (int j = 0; j < 8; ++j) { const v4u a = *(const v4u*)(srow + 512 * j), b = *(const v4u*)(srow + 512 * j + 16);
          v4u o; o.x = pack4_i8(bflo(a.x) * inv, bfhi(a.x) * inv, bflo(a.y) * inv, bfhi(a.y) * inv); o.y = pack4_i8(bflo(a.z) * inv, bfhi(a.z) * inv, bflo(a.w) * inv, bfhi(a.w) * inv);
          o.z = pack4_i8(bflo(b.x) * inv, bfhi(b.x) * inv, bflo(b.y) * inv, bfhi(b.y) * inv); o.w = pack4_i8(bflo(b.z) * inv, bfhi(b.z) * inv, bflo(b.w) * inv, bfhi(b.w) * inv);
          *(v4u*)(drow + 256 * j) = o; } }
    __syncthreads();
}
constexpr int CW_Q = 8192;
__device__ __forceinline__ void phase_convert(Frame& F) {
    static_assert(MK_QKV0_I8 && MK_QKV1_I8, "the int8 slabs below cover both QKV projections");
    { constexpr int S_Q = NQKV / 32, S_FI = 2 * DFF / 32, S_O = DM / 32;
      for (int u = blockIdx.x; u < 2 * S_Q + S_FI + 2 * S_O; u += F.G) {
          if (u < S_Q) i8_slab(F, F.w_qkv, NQKV, (unsigned char*)F.WQKV, 0, F.WSCQKV0, u);
          else if (u < 2 * S_Q) i8_slab(F, F.w_qkv + (size_t)DM * NQKV, NQKV, (unsigned char*)(F.WQKV + (size_t)NQKV * DM), 0, F.WSCQKV, u - S_Q);
          else if (u < 2 * S_Q + S_FI) i8_slab(F, F.ffn_w_in, 2 * DFF, (unsigned char*)F.WFI, DFF, F.WSCFI, u - 2 * S_Q);
          else { const int v = u - 2 * S_Q - S_FI, l = v / S_O; i8_slab(F, F.w_o + (size_t)l * DM * DM, DM, (unsigned char*)F.WO + (size_t)l * DM * DM, 0, F.WSCO + l * DM, v - l * S_O); } } }
    float* scr = (float*)(F.lds + F.wave * 16896);
    constexpr int I_FO = (DFF / 128) * (DM / 32)  ;
    constexpr int I_MI = (DM / 128) * (2 * DFE / 32)  , I_MO = (DFE / 128) * (DM / 32);
    constexpr int NITEMS = I_FO + 8 * I_MI + 8 * I_MO;
    static_assert(NITEMS % 64 == 0, "items are taken eight at a time, interleaved inside groups of 64");
    int cur = 0; if (F.lane == 0) cur = (int)__hip_atomic_fetch_add(F.ctl + CW_Q, 8u, __ATOMIC_RELAXED, __HIP_MEMORY_SCOPE_AGENT); cur = __builtin_amdgcn_readfirstlane(cur);
    while (cur < NITEMS) {
        int nxt = 0; if (F.lane == 0) nxt = (int)__hip_atomic_fetch_add(F.ctl + CW_Q, 8u, __ATOMIC_RELAXED, __HIP_MEMORY_SCOPE_AGENT);
        const int ibase = 64 * (cur >> 6) + ((cur >> 3) & 7);
        for (int i8 = 0; i8 < 8; ++i8) { const int it = ibase + 8 * i8;
            int r = it;
            if (r < I_FO) { transpose_item_f8(F.ffn_w_out, DFF, DM, (unsigned char*)F.WFO, 0, 64.0f, scr, r, F.lane); continue; } r -= I_FO;
            if (r < 8 * I_MI) { const int e = r / I_MI; r -= e * I_MI; transpose_item_f8(F.moe_w_in + (size_t)e * DM * 2 * DFE, DM, 2 * DFE, (unsigned char*)F.WMI + (size_t)e * 2 * DFE * DM, DFE, 64.0f, scr, r, F.lane); continue; } r -= 8 * I_MI;
            { const int e = r / I_MO; r -= e * I_MO; transpose_item_f8(F.moe_w_out + (size_t)e * DFE * DM, DFE, DM, (unsigned char*)F.WMO + (size_t)e * DM * DFE, 0, 128.0f, scr, r, F.lane); }
        }
        cur = __builtin_amdgcn_readfirstlane(nxt);
    }
}

__device__ __forceinline__ void phase_rowq(Frame& F, const bf16* A, unsigned char* Q) {
    const int gw = F.vcu * NWAVES + F.wave, NGW = F.G * NWAVES;
    for (int rb = gw; rb < M / 8; rb += NGW) {
        const int m0 = rb * 8;
#pragma unroll
        for (int i0 = 0; i0 < 8; i0 += 4) {
            v2u raw[4][8];
#pragma unroll
            for (int r = 0; r < 4; ++r)
#pragma unroll
                for (int j = 0; j < 8; ++j) raw[r][j] = *(const v2u*)(A + (size_t)(m0 + i0 + r) * DM + 4 * F.lane + 256 * j);
#pragma unroll
            for (int r = 0; r < 4; ++r) { const int i = i0 + r;
                f32x4 v[8]; float am = 0.f;
#pragma unroll
                for (int j = 0; j < 8; ++j) { v[j] = (f32x4){bflo(raw[r][j].x), bfhi(raw[r][j].x), bflo(raw[r][j].y), bfhi(raw[r][j].y)}; am = fmaxf(am, fmaxf(fmaxf(fabsf(v[j][0]), fabsf(v[j][1])), fmaxf(fabsf(v[j][2]), fabsf(v[j][3])))); }
                am = fmaxf(wave_max(am), 1e-30f); const float inv = 127.0f / am;
                unsigned char* orow = Q + (size_t)(m0 + i) * DM + 4 * F.lane;
#pragma unroll
                for (int j = 0; j < 8; ++j) *(unsigned*)(orow + 256 * j) = pack4_i8_nc(v[j][0] * inv, v[j][1] * inv, v[j][2] * inv, v[j][3] * inv);
                if (F.lane == 0) F.HSCALE[m0 + i] = am * (1.0f / 127.0f); }
        }
    }
}

template <bool XB16> __device__ __forceinline__ f32x4 ld4x(const void* base, size_t idx) {
    if constexpr (XB16) { const v2u w = *(const v2u*)((const bf16*)base + idx); return (f32x4){bflo(w.x), bfhi(w.x), bflo(w.y), bfhi(w.y)}; }
    else return *(const f32x4*)((const float*)base + idx);
}
template <bool XB16> struct RawRow { typedef f32x4 T; }; template <> struct RawRow<true> { typedef v2u T; };
template <bool XB16> __device__ __forceinline__ typename RawRow<XB16>::T ldraw(const void* base, size_t idx) {
    if constexpr (XB16) return *(const v2u*)((const bf16*)base + idx); else return *(const f32x4*)((const float*)base + idx);
}
__device__ __forceinline__ f32x4 unraw(const v2u w) { return (f32x4){bflo(w.x), bfhi(w.x), bflo(w.y), bfhi(w.y)}; }
__device__ __forceinline__ f32x4 unraw(const f32x4 w) { return w; }
template <bool I8OUT, bool XB16> __device__ __forceinline__ void phase_norm(Frame& F, const void* X, const float* gain, int l, int ch_sh, int ch_sc, bf16* HB) {
    const int gw = F.vcu * NWAVES + F.wave, NGW = F.G * NWAVES;
    for (int rb = gw; rb < M / 8; rb += NGW) {
        const int m0 = rb * 8, b = m0 / SEQ;
        const float* modb = F.MOD + (size_t)(l * 8 + b) * NMOD;
        f32x4 a[8], s[8];
#pragma unroll
        for (int j = 0; j < 8; ++j) { const int col = 4 * F.lane + 256 * j; const f32x4 g = *(const f32x4*)(gain + col), sc = *(const f32x4*)(modb + ch_sc * DM + col); a[j] = g * (sc + 1.0f); s[j] = *(const f32x4*)(modb + ch_sh * DM + col); }
#pragma unroll
        for (int i0 = 0; i0 < 8; i0 += 4) {
            typename RawRow<XB16>::T raw[4][8];
#pragma unroll
            for (int r = 0; r < 4; ++r)
#pragma unroll
                for (int j = 0; j < 8; ++j) raw[r][j] = ldraw<XB16>(X, (size_t)(m0 + i0 + r) * DM + 4 * F.lane + 256 * j);
#pragma unroll
            for (int r = 0; r < 4; ++r) { const int i = i0 + r;
                f32x4 v[8]; float ss = 0.f;
#pragma unroll
                for (int j = 0; j < 8; ++j) { v[j] = unraw(raw[r][j]); ss += (v[j][0] * v[j][0] + v[j][1] * v[j][1]) + (v[j][2] * v[j][2] + v[j][3] * v[j][3]); }
                const float rstd = 1.0f / sqrtf(wave_sum(ss) * (1.0f / DM) + EPS);
                if constexpr (I8OUT) {
                    float am = 0.f;
#pragma unroll
                    for (int j = 0; j < 8; ++j) { v[j] = v[j] * rstd * a[j] + s[j]; am = fmaxf(am, fmaxf(fmaxf(fabsf(v[j][0]), fabsf(v[j][1])), fmaxf(fabsf(v[j][2]), fabsf(v[j][3])))); }
                    am = fmaxf(wave_max(am), 1e-30f); const float inv = 127.0f / am;
                    unsigned char* orow = (unsigned char*)HB + (size_t)(m0 + i) * DM + 4 * F.lane;
#pragma unroll
                    for (int j = 0; j < 8; ++j) *(unsigned*)(orow + 256 * j) = pack4_i8_nc(v[j][0] * inv, v[j][1] * inv, v[j][2] * inv, v[j][3] * inv);
                    if (F.lane == 0) F.HSCALE[m0 + i] = am * (1.0f / 127.0f); }
                else { bf16* orow = HB + (size_t)(m0 + i) * DM + 4 * F.lane;
#pragma unroll
                    for (int j = 0; j < 8; ++j) { const f32x4 h = v[j] * rstd * a[j] + s[j]; v2u o; o.x = pk2(h[0], h[1]); o.y = pk2(h[2], h[3]); *(v2u*)(orow + 256 * j) = o; } }
            }
        }
    }
}

typedef short bf16x8 __attribute__((ext_vector_type(8)));
typedef float f32x16 __attribute__((ext_vector_type(16)));
typedef float f32x2_t __attribute__((ext_vector_type(2))); typedef __bf16 bf16x2_t __attribute__((ext_vector_type(2)));
__device__ __forceinline__ unsigned cvtpk(float lo, float hi) { f32x2_t v = {lo, hi}; bf16x2_t b = __builtin_convertvector(v, bf16x2_t); return __builtin_bit_cast(unsigned, b); }
__device__ __forceinline__ void xhalf(float x, float& lo, float& hi) { const unsigned a = __builtin_bit_cast(unsigned, x); auto rr = __builtin_amdgcn_permlane32_swap(a, a, false, false); const unsigned x0 = rr[0], x1 = rr[1]; lo = __builtin_bit_cast(float, x0); hi = __builtin_bit_cast(float, x1); }
#define PK4(P, B_, OUT) do { unsigned a0_ = cvtpk(P[B_+0], P[B_+1]), a1_ = cvtpk(P[B_+2], P[B_+3]); unsigned b0_ = cvtpk(P[B_+4], P[B_+5]), b1_ = cvtpk(P[B_+6], P[B_+7]);  \
        auto r0_ = __builtin_amdgcn_permlane32_swap(a0_, b0_, false, false); auto r1_ = __builtin_amdgcn_permlane32_swap(a1_, b1_, false, false); \
        v4u w_ = {r0_[0], r1_[0], r0_[1], r1_[1]}; OUT = __builtin_bit_cast(bf16x8, w_); } while (0)
__device__ __forceinline__ v4u pair16(unsigned a0, unsigned a1, unsigned b0, unsigned b1) {
    auto r0_ = __builtin_amdgcn_permlane32_swap(a0, b0, false, false); auto r1_ = __builtin_amdgcn_permlane32_swap(a1, b1, false, false);
    v4u w_ = {r0_[0], r1_[0], r0_[1], r1_[1]}; return w_; }
constexpr int QKP = 2 * DM;

__device__ __forceinline__ void phase_sb(Frame& F) {
    const int gw = F.vcu * NWAVES + F.wave, NGW = F.G * NWAVES, lane = F.lane, r32 = lane & 31, hi = lane >> 5;
    constexpr float C = -ATT_SCALE * LOG2E;
    for (int item = gw; item < NB * NH * (SEQ / 32); item += NGW) {
        const int bh = item >> 6, qt = item & 63, b = bh >> 4, h = bh & 15, q0 = qt * 32;
        const bf16* Qp = F.QK + (size_t)(b * SEQ + q0 + r32) * QKP + h * HD + hi * 8;
        bf16x8 qr[8];
#pragma unroll
        for (int d0 = 0; d0 < 8; ++d0) qr[d0] = *(const bf16x8*)(Qp + d0 * 16);
        const bf16* Kb = F.QK + (size_t)(b * SEQ + r32) * QKP + DM + h * HD + hi * 8;
        const bf16* Vb = F.VT + (size_t)(h * HD + r32) * M + b * SEQ + hi * 8;
        f32x16 o[4];
#pragma unroll
        for (int d0 = 0; d0 < 4; ++d0)
#pragma unroll
            for (int r = 0; r < 16; ++r) o[d0][r] = 0.f;
        float carry = 1.0f;
        bf16x8 kf[8], kn[8], vf[8];
#pragma unroll
        for (int d0 = 0; d0 < 8; ++d0) kf[d0] = *(const bf16x8*)(Kb + (size_t)q0 * QKP + d0 * 16);
        for (int j = qt; j >= 0; --j) {
            const int kb = j * 32, jn = j > 0 ? j - 1 : 0;
#pragma unroll
            for (int i = 0; i < 8; ++i) vf[i] = *(const bf16x8*)(Vb + (size_t)((i >> 1) * 32) * M + kb + (i & 1) * 16);
#pragma unroll
            for (int d0 = 0; d0 < 8; ++d0) kn[d0] = *(const bf16x8*)(Kb + (size_t)(jn * 32) * QKP + d0 * 16);
            f32x16 p;
#pragma unroll
            for (int r = 0; r < 16; ++r) p[r] = 0.f;
#pragma unroll
            for (int d0 = 0; d0 < 8; ++d0) p = __builtin_amdgcn_mfma_f32_32x32x16_bf16(kf[d0], qr[d0], p, 0, 0, 0);
            float beta[16], keep[16];
            const bool diag = (j == qt);
#pragma unroll
            for (int r = 0; r < 16; ++r) {
                const float e = __builtin_amdgcn_exp2f(fminf(p[r] * C, 126.0f));
                float bt = __builtin_amdgcn_rcpf(1.0f + e), kp = e * bt;
                if (diag) { const bool valid = ((r & 3) + 8 * (r >> 2) + 4 * hi) < r32; kp = valid ? kp : 1.0f; bt = valid ? bt : 0.f; }
                beta[r] = bt; keep[r] = kp;
            }
            float e2[4], e1[4], e0[4], Ge[4], Go[4];
#pragma unroll
            for (int k = 0; k < 4; ++k) { e2[k] = keep[4 * k + 3]; e1[k] = e2[k] * keep[4 * k + 2]; e0[k] = e1[k] * keep[4 * k + 1]; const float g = e0[k] * keep[4 * k];
                xhalf(g, Ge[k], Go[k]); }
            float Te[4], To[4];
            To[3] = 1.0f; Te[3] = Go[3]; To[2] = Te[3] * Ge[3]; Te[2] = To[2] * Go[2]; To[1] = Te[2] * Ge[2]; Te[1] = To[1] * Go[1]; To[0] = Te[1] * Ge[1]; Te[0] = To[0] * Go[0];
            const float total = Te[0] * Ge[0];
#pragma unroll
            for (int k = 0; k < 4; ++k) { const float ck = carry * (hi ? To[k] : Te[k]);
                p[4 * k + 3] = beta[4 * k + 3] * ck; p[4 * k + 2] = beta[4 * k + 2] * (ck * e2[k]); p[4 * k + 1] = beta[4 * k + 1] * (ck * e1[k]); p[4 * k] = beta[4 * k] * (ck * e0[k]); }
            carry *= total;
            bf16x8 pa0, pa1; PK4(p, 0, pa0); PK4(p, 8, pa1);
#pragma unroll
            for (int d0 = 0; d0 < 4; ++d0) { o[d0] = __builtin_amdgcn_mfma_f32_32x32x16_bf16(vf[2 * d0], pa0, o[d0], 0, 0, 0); o[d0] = __builtin_amdgcn_mfma_f32_32x32x16_bf16(vf[2 * d0 + 1], pa1, o[d0], 0, 0, 0); }
#pragma unroll
            for (int d0 = 0; d0 < 8; ++d0) kf[d0] = kn[d0];
            if (__all(carry < 2.3283064e-10f)) break;
        }
        bf16* Op = F.AO + (size_t)(b * SEQ + q0 + r32) * DM + h * HD + 8 * hi;
#pragma unroll
        for (int d0 = 0; d0 < 4; ++d0)
#pragma unroll
            for (int g = 0; g < 4; g += 2)
                *(v4u*)(Op + d0 * 32 + 8 * g) = pair16(cvtpk(o[d0][4 * g], o[d0][4 * g + 1]), cvtpk(o[d0][4 * g + 2], o[d0][4 * g + 3]), cvtpk(o[d0][4 * g + 4], o[d0][4 * g + 5]), cvtpk(o[d0][4 * g + 6], o[d0][4 * g + 7]));
    }
}

__device__ __forceinline__ void phase_qknorm(Frame& F) {
    float* part = (float*)F.lds;
    const int lane = F.lane, c = lane & 15, rs = lane >> 4;
    const f32x4 g0 = *(const f32x4*)(F.qn_k + 8 * c), g1 = *(const f32x4*)(F.qn_k + 8 * c + 4);
    for (int u = blockIdx.x; u < NB * 8 * NH; u += F.G) {
        const int h = u & 15, blk = (u >> 4) & 7, b = u >> 7;
        bf16* base = F.QK + (size_t)(b * SEQ + blk * 256 + F.wave * 32 + rs) * QKP + DM + h * HD + 8 * c;
        v4u kp[8];
#pragma unroll
        for (int i = 0; i < 8; ++i) kp[i] = *(const v4u*)(base + (size_t)(4 * i) * QKP);
        f32x4 ks0 = (f32x4){0.f, 0.f, 0.f, 0.f}, ks1 = ks0;
#pragma unroll
        for (int i = 0; i < 8; ++i) {
            const f32x4 k0 = (f32x4){bflo(kp[i].x), bfhi(kp[i].x), bflo(kp[i].y), bfhi(kp[i].y)}, k1 = (f32x4){bflo(kp[i].z), bfhi(kp[i].z), bflo(kp[i].w), bfhi(kp[i].w)};
            float sq = ((k0[0] * k0[0] + k0[1] * k0[1]) + (k0[2] * k0[2] + k0[3] * k0[3])) + ((k1[0] * k1[0] + k1[1] * k1[1]) + (k1[2] * k1[2] + k1[3] * k1[3]));
            sq += dppf<0xB1>(sq); sq += dppf<0x4E>(sq); sq += dppf<0x141>(sq); sq += dppf<0x140>(sq);
            const float rk = 1.0f / sqrtf(sq * (1.0f / HD) + EPS);
            const f32x4 n0 = k0 * rk * g0, n1 = k1 * rk * g1;
            ks0 += n0; ks1 += n1;
            v4u o; o.x = pk2(n0[0], n0[1]); o.y = pk2(n0[2], n0[3]); o.z = pk2(n1[0], n1[1]); o.w = pk2(n1[2], n1[3]);
            *(v4u*)(base + (size_t)(4 * i) * QKP) = o;
        }
#pragma unroll
        for (int e = 0; e < 4; ++e) { ks0[e] += __shfl_xor(ks0[e], 16); ks0[e] += __shfl_xor(ks0[e], 32); ks1[e] += __shfl_xor(ks1[e], 16); ks1[e] += __shfl_xor(ks1[e], 32); }
        if (rs == 0) { *(f32x4*)(part + F.wave * 128 + 8 * c) = ks0; *(f32x4*)(part + F.wave * 128 + 8 * c + 4) = ks1; }
        __syncthreads();
        if (F.tid < 128) { float sm = 0.f;
#pragma unroll
            for (int w = 0; w < 8; ++w) sm += part[w * 128 + F.tid];
            F.KMEAN[((size_t)(b * NH + h) * 8 + blk) * HD + F.tid] = sm * (1.0f / 256.0f); }
        __syncthreads();
    }
}

#define SBAR() __builtin_amdgcn_sched_barrier(0)
__device__ __forceinline__ void phase_moba(Frame& F) {
    const int lane = F.lane, r32 = lane & 31, hi = lane >> 5, w = F.wave;
    PG8_LAS unsigned char* ldsl = (PG8_LAS unsigned char*)F.lds;
    const float bound2 = 2.0f * (ATT_SCALE * LOG2E) * (float)HD * wave_max(fmaxf(fabsf(F.qn_q[2 * lane]), fabsf(F.qn_q[2 * lane + 1]))) * wave_max(fmaxf(fabsf(F.qn_k[2 * lane]), fabsf(F.qn_k[2 * lane + 1])));
    for (int P = F.vcu; P < NB * NH * 4; P += F.G) {
      const int bh = P >> 2, b = bh >> 4, h = (P >= NB * NH * 2) ? 15 - (bh & 15) : (bh & 15);
      for (int half = 0; half < 2; ++half) {
        const int qb = half ? 7 - (P & 3) : (P & 3), q0 = qb * 256 + 32 * w, t = q0 + r32, NT = 8 * (qb + 1);
        const float slope2 = exp2f(-0.5f * (float)(h + 1)) * LOG2E;
        const int Dk = (int)fminf((58.0f + bound2) / slope2 + 1.0f, 4096.0f);
        const int jbeg = (qb * 256 - Dk) > 0 ? (qb * 256 - Dk) >> 5 : 0;
        const int jfirst = (q0 - Dk) > 0 ? (q0 - Dk) >> 5 : 0;
        const bf16* Qp = F.QK + (size_t)(b * SEQ + t) * QKP + h * HD + hi * 8;
        const int ktid = w * 64 + lane; const bool kst_on = ktid < 32 * qb; f32x4 kst = {0.f, 0.f, 0.f, 0.f};
        if (kst_on) kst = *(const f32x4*)(F.KMEAN + ((size_t)(b * NH + h) * 8) * HD + 4 * ktid);
        bf16x8 qr[8];
#pragma unroll
        for (int d0 = 0; d0 < 8; ++d0) qr[d0] = *(const bf16x8*)(Qp + d0 * 16);
        { float ss = 0.f;
#pragma unroll
          for (int d0 = 0; d0 < 8; ++d0) { const v4u qq = __builtin_bit_cast(v4u, qr[d0]); ss += bflo(qq.x) * bflo(qq.x) + bfhi(qq.x) * bfhi(qq.x) + bflo(qq.y) * bflo(qq.y) + bfhi(qq.y) * bfhi(qq.y) + bflo(qq.z) * bflo(qq.z) + bfhi(qq.z) * bfhi(qq.z) + bflo(qq.w) * bflo(qq.w) + bfhi(qq.w) * bfhi(qq.w); }
          float slo, shi; xhalf(ss, slo, shi); const float rq = (ATT_SCALE * LOG2E) / sqrtf((slo + shi) * (1.0f / HD) + EPS);
#pragma unroll
          for (int d0 = 0; d0 < 8; ++d0) { const f32x4 g0 = *(const f32x4*)(F.qn_q + d0 * 16 + hi * 8) * rq, g1 = *(const f32x4*)(F.qn_q + d0 * 16 + hi * 8 + 4) * rq; const v4u qq = __builtin_bit_cast(v4u, qr[d0]);
              v4u o; o.x = cvtpk(bflo(qq.x) * g0[0], bfhi(qq.x) * g0[1]); o.y = cvtpk(bflo(qq.y) * g0[2], bfhi(qq.y) * g0[3]); o.z = cvtpk(bflo(qq.z) * g1[0], bfhi(qq.z) * g1[1]); o.w = cvtpk(bflo(qq.w) * g1[2], bfhi(qq.w) * g1[3]);
              qr[d0] = __builtin_bit_cast(bf16x8, o); } }
        const bf16* src0; const bf16* src1; size_t tstep;
        if (w < 4) { src0 = F.QK + (size_t)(b * SEQ + r32) * QKP + DM + h * HD + hi * 8 + (2 * w) * 16; src1 = src0 + 16; tstep = (size_t)32 * QKP; }
        else { src0 = F.VT + (size_t)(h * HD + (w - 4) * 32 + r32) * M + b * SEQ + hi * 8; src1 = src0 + 16; tstep = 32; }
        const unsigned dst0 = (unsigned)(w < 4 ? (2 * w) * 1024 : (8 + 2 * (w - 4)) * 1024);
#define MOBA_ISSUE(j_, boff_) do { __builtin_amdgcn_global_load_lds((const unsigned*)(src0 + (size_t)(j_) * tstep), (PG8_LAS unsigned*)(ldsl + (boff_) + dst0), 16, 0, 0); \
                                   __builtin_amdgcn_global_load_lds((const unsigned*)(src1 + (size_t)(j_) * tstep), (PG8_LAS unsigned*)(ldsl + (boff_) + dst0 + 1024), 16, 0, 0); } while (0)
        int bv = 65536, bk = 81920, bn = 0, bn2 = 16384, bn3 = 32768, bn4 = 49152;
        MOBA_ISSUE(jbeg, 0); MOBA_ISSUE(jbeg + 1, 16384); MOBA_ISSUE(jbeg + 2, 32768); MOBA_ISSUE(jbeg + 3, 49152);
        unsigned sel = 0u;
        PG8_LAS float* kms = (PG8_LAS float*)(ldsl + 6 * 16384);
        if (kst_on) *(PG8_LAS f32x4*)(kms + 4 * ktid) = kst;
        asm volatile("s_waitcnt lgkmcnt(0)" ::: "memory"); __builtin_amdgcn_s_barrier(); asm volatile("" ::: "memory");
        { float gate[7];
#pragma unroll
          for (int n = 0; n < 7; ++n) { gate[n] = 0.f; if (n < qb) { PG8_LAS const float* km = kms + n * HD + hi * 8; float sg = 0.f;
#pragma unroll
                for (int d0 = 0; d0 < 8; ++d0) { const f32x4 k0 = *(PG8_LAS const f32x4*)(km + d0 * 16), k1 = *(PG8_LAS const f32x4*)(km + d0 * 16 + 4); const v4u qq = __builtin_bit_cast(v4u, qr[d0]);
                    sg += bflo(qq.x) * k0[0] + bfhi(qq.x) * k0[1] + bflo(qq.y) * k0[2] + bfhi(qq.y) * k0[3] + bflo(qq.z) * k1[0] + bfhi(qq.z) * k1[1] + bflo(qq.w) * k1[2] + bfhi(qq.w) * k1[3]; }
                float glo, ghi; xhalf(sg, glo, ghi); gate[n] = glo + ghi; } }
#pragma unroll
          for (int n = 0; n < 7; ++n) if (n < qb) { int rank = 0;
#pragma unroll
              for (int m2 = 0; m2 < 7; ++m2) if (m2 != n && m2 < qb) rank += (gate[m2] > gate[n] || (gate[m2] == gate[n] && m2 < n)) ? 1 : 0;
              if (rank < 3) sel |= 1u << n; } }
        f32x16 o[4];
#pragma unroll
        for (int d0 = 0; d0 < 4; ++d0)
#pragma unroll
            for (int r = 0; r < 16; ++r) o[d0][r] = 0.f;
        float m_reg = -1e30f, l_reg = 0.f;
        const int jlast = 8 * qb + w;
        const float NEG = -__builtin_inff();
        f32x16 pA, pB; bf16x8 kf[8], vf[8], pa0, pa1;
#define MOBA_TOP(j_) do { { const int rem_ = NT - 1 - (j_);     \
              if (rem_ >= 3) asm volatile("s_waitcnt vmcnt(6) lgkmcnt(0)" ::: "memory"); else if (rem_ == 2) asm volatile("s_waitcnt vmcnt(4) lgkmcnt(0)" ::: "memory"); \
              else if (rem_ == 1) asm volatile("s_waitcnt vmcnt(2) lgkmcnt(0)" ::: "memory"); else asm volatile("s_waitcnt vmcnt(0) lgkmcnt(0)" ::: "memory"); } \
            __builtin_amdgcn_s_barrier(); asm volatile("" ::: "memory"); { const int t_ = bv; bv = bk; bk = bn; bn = bn2; bn2 = bn3; bn3 = bn4; bn4 = t_; } if ((j_) + 4 < NT) MOBA_ISSUE((j_) + 4, bn4); } while (0)
#define MOBA_LDK() do { PG8_LAS const unsigned char* kb_ = ldsl + bk + lane * 16; _Pragma("unroll") for (int i = 0; i < 8; ++i) kf[i] = *(PG8_LAS const bf16x8*)(kb_ + i * 1024); } while (0)
#define MOBA_LDKH(h_) do { PG8_LAS const unsigned char* kb_ = ldsl + bk + lane * 16 + (h_) * 4096; _Pragma("unroll") for (int i = 0; i < 4; ++i) kf[(h_) * 4 + i] = *(PG8_LAS const bf16x8*)(kb_ + i * 1024); } while (0)
#define MOBA_LDVH(boff_, h_) do { PG8_LAS const unsigned char* vb_ = ldsl + (boff_) + 8192 + lane * 16 + (h_) * 4096; _Pragma("unroll") for (int i = 0; i < 4; ++i) vf[(h_) * 4 + i] = *(PG8_LAS const bf16x8*)(vb_ + i * 1024); } while (0)
#define MOBA_LDV(boff_) do { PG8_LAS const unsigned char* vb_ = ldsl + (boff_) + 8192 + lane * 16; _Pragma("unroll") for (int i = 0; i < 8; ++i) vf[i] = *(PG8_LAS const bf16x8*)(vb_ + i * 1024); } while (0)
#define MOBA_INIT(PN, j_) do { const float ab_ = slope2 * (float)((j_) * 32 + 4 * hi - t); _Pragma("unroll") for (int r = 0; r < 16; ++r) PN[r] = fmaf(slope2, (float)((r & 3) + 8 * (r >> 2)), ab_); } while (0)
#define MOBA_QK(PN, d_) PN = __builtin_amdgcn_mfma_f32_32x32x16_bf16(kf[d_], qr[d_], PN, 0, 0, 0)
#define SM_MAXA(PC) float mx_ = fmaxf(fmaxf(fmaxf(PC[0], PC[1]), fmaxf(PC[2], PC[3])), fmaxf(fmaxf(PC[4], PC[5]), fmaxf(PC[6], PC[7])))
#define SM_MAXB(PC) mx_ = fmaxf(mx_, fmaxf(fmaxf(fmaxf(PC[8], PC[9]), fmaxf(PC[10], PC[11])), fmaxf(fmaxf(PC[12], PC[13]), fmaxf(PC[14], PC[15]))))
#define SM_DECIDE() do { float mlo_, mhi_; xhalf(mx_, mlo_, mhi_); mx_ = fmaxf(mlo_, mhi_); \
            if (!__all(mx_ - m_reg <= 8.0f)) { const float mn_ = fmaxf(m_reg, mx_), alpha_ = __builtin_amdgcn_exp2f(m_reg - mn_); m_reg = mn_; l_reg *= alpha_; \
                _Pragma("unroll") for (int d0 = 0; d0 < 4; ++d0) _Pragma("unroll") for (int r = 0; r < 16; ++r) o[d0][r] *= alpha_; } } while (0)
#define SM_EXP4(PC, B_) do { PC[B_] = __builtin_amdgcn_exp2f(PC[B_] - m_reg); PC[B_ + 1] = __builtin_amdgcn_exp2f(PC[B_ + 1] - m_reg); PC[B_ + 2] = __builtin_amdgcn_exp2f(PC[B_ + 2] - m_reg); PC[B_ + 3] = __builtin_amdgcn_exp2f(PC[B_ + 3] - m_reg); \
            ps_ += (PC[B_] + PC[B_ + 1]) + (PC[B_ + 2] + PC[B_ + 3]); } while (0)
#define MOBA_PV() do { _Pragma("unroll") for (int d0 = 0; d0 < 4; ++d0) { o[d0] = __builtin_amdgcn_mfma_f32_32x32x16_bf16(vf[2 * d0], pa0, o[d0], 0, 0, 0); o[d0] = __builtin_amdgcn_mfma_f32_32x32x16_bf16(vf[2 * d0 + 1], pa1, o[d0], 0, 0, 0); } } while (0)
#define MOBA_STEP(PN, PC, j_) do { MOBA_LDKH(0); MOBA_INIT(PN, j_); \
            { const int n1_ = ((j_) - 1) >> 3; if (n1_ < qb) { if (!((sel >> n1_) & 1u)) { _Pragma("unroll") for (int r = 0; r < 16; ++r) PC[r] = NEG; } } } \
            SBAR(); MOBA_QK(PN, 0); SM_MAXA(PC); SBAR(); MOBA_QK(PN, 1); MOBA_LDKH(1); SM_MAXB(PC); SBAR(); MOBA_QK(PN, 2); SM_DECIDE(); float ps_ = 0.f; SBAR(); \
            MOBA_QK(PN, 3); SM_EXP4(PC, 0); SBAR(); MOBA_QK(PN, 4); SM_EXP4(PC, 4); SBAR(); MOBA_QK(PN, 5); MOBA_LDVH(bv, 0); SM_EXP4(PC, 8); SBAR(); MOBA_QK(PN, 6); SM_EXP4(PC, 12); SBAR(); \
            MOBA_QK(PN, 7); MOBA_LDVH(bv, 1); l_reg += ps_; PK4(PC, 0, pa0); PK4(PC, 8, pa1); SBAR(); MOBA_PV(); } while (0)
#define MOBA_DRAIN(PC) do { MOBA_LDV(bk); \
            _Pragma("unroll") for (int r = 0; r < 16; ++r) if (((r & 3) + 8 * (r >> 2) + 4 * hi) > r32) PC[r] = NEG; \
            SM_MAXA(PC); SM_MAXB(PC); SM_DECIDE(); float ps_ = 0.f; SM_EXP4(PC, 0); SM_EXP4(PC, 4); SM_EXP4(PC, 8); SM_EXP4(PC, 12); l_reg += ps_; PK4(PC, 0, pa0); PK4(PC, 8, pa1); MOBA_PV(); } while (0)
        for (int jj = jbeg; jj < jfirst; ++jj) MOBA_TOP(jj);
        MOBA_TOP(jfirst); MOBA_LDK(); MOBA_INIT(pA, jfirst);
#pragma unroll
        for (int d0 = 0; d0 < 8; ++d0) MOBA_QK(pA, d0);
        for (int j = jfirst + 1; j <= jlast; ++j) { pB = pA; MOBA_TOP(j); MOBA_STEP(pA, pB, j); }
        pB = pA; MOBA_DRAIN(pB);
        for (int jj = jlast + 1; jj < NT; ++jj) MOBA_TOP(jj);
        { float llo, lhi; xhalf(l_reg, llo, lhi); l_reg = llo + lhi; }
        const float il = 1.0f / l_reg;
        bf16* Op = F.AO + (size_t)(b * SEQ + t) * DM + h * HD + 8 * hi;
#pragma unroll
        for (int d0 = 0; d0 < 4; ++d0)
#pragma unroll
            for (int g = 0; g < 4; g += 2)
                *(v4u*)(Op + d0 * 32 + 8 * g) = pair16(cvtpk(o[d0][4 * g] * il, o[d0][4 * g + 1] * il), cvtpk(o[d0][4 * g + 2] * il, o[d0][4 * g + 3] * il), cvtpk(o[d0][4 * g + 4] * il, o[d0][4 * g + 5] * il), cvtpk(o[d0][4 * g + 6] * il, o[d0][4 * g + 7] * il));
        __syncthreads();
      }
    }
#undef MOBA_ISSUE
#undef MOBA_TOP
#undef MOBA_LDK
#undef MOBA_LDV
#undef MOBA_INIT
#undef MOBA_QK
#undef SM_MAXA
#undef SM_MAXB
#undef SM_DECIDE
#undef SM_EXP4
#undef MOBA_PV
#undef MOBA_STEP
#undef MOBA_DRAIN
}
#undef SBAR

__device__ __forceinline__ void phase_router(Frame& F, const bf16* X) {
    float* wr = (float*)F.lds;
    int* selE = (int*)(F.lds + 65536); float* selW = (float*)(F.lds + 65536 + 1024); int* selR = (int*)(F.lds + 65536 + 2048);
    for (int i = F.tid; i < DM * NE; i += NWAVES * 64) { const int col = i >> 3, e = i & 7, j = col >> 8, ln = (col & 255) >> 2, c = col & 3; wr[((j * 4 + c) * 64 + ln) * 8 + e] = F.router_w[i]; }
    __syncthreads();
    const int lane = F.lane;
    for (int grp = blockIdx.x; grp < M / 64; grp += F.G) {
        const int m0 = grp * 64 + F.wave * 8, b = (grp * 64) / SEQ;
        const float* modb = F.MOD + (size_t)(8 + b) * NMOD;
        f32x4 a[8], s[8];
#pragma unroll
        for (int j = 0; j < 8; ++j) { const int col = 4 * lane + 256 * j; const f32x4 g = *(const f32x4*)(F.ffn_norm + DM + col), sc = *(const f32x4*)(modb + 4 * DM + col); a[j] = g * (sc + 1.0f); s[j] = *(const f32x4*)(modb + 3 * DM + col); }
#pragma unroll 1
        for (int i0 = 0; i0 < 8; i0 += 4) {
          v2u raw[4][8];
#pragma unroll
          for (int r = 0; r < 4; ++r)
#pragma unroll
            for (int j = 0; j < 8; ++j) raw[r][j] = *(const v2u*)(X + (size_t)(m0 + i0 + r) * DM + 4 * lane + 256 * j);
#pragma unroll
          for (int r = 0; r < 4; ++r) { const int i = i0 + r;
            f32x4 v[8]; float ss = 0.f;
#pragma unroll
            for (int j = 0; j < 8; ++j) { v[j] = unraw(raw[r][j]); ss += (v[j][0] * v[j][0] + v[j][1] * v[j][1]) + (v[j][2] * v[j][2] + v[j][3] * v[j][3]); }
            const float rstd = 1.0f / sqrtf(wave_sum(ss) * (1.0f / DM) + EPS);
            float pe[8];
            { f32x4 pa = {0.f, 0.f, 0.f, 0.f}, pb = pa;
#pragma unroll
              for (int j = 0; j < 8; ++j) { const f32x4 hh = v[j] * rstd * a[j] + s[j];
#pragma unroll
                for (int c = 0; c < 4; ++c) { const float* wp = wr + ((j * 4 + c) * 64 + lane) * 8; const f32x4 w0 = *(const f32x4*)wp, w1 = *(const f32x4*)(wp + 4);
                    pa += w0 * hh[c]; pb += w1 * hh[c]; } }
              pe[0] = pa[0]; pe[1] = pa[1]; pe[2] = pa[2]; pe[3] = pa[3]; pe[4] = pb[0]; pe[5] = pb[1]; pe[6] = pb[2]; pe[7] = pb[3]; }
#pragma unroll
            for (int e = 0; e < 8; ++e) pe[e] = wave_sum(pe[e]);
            int e0 = 0; float l0 = pe[0];
#pragma unroll
            for (int e = 1; e < 8; ++e) if (pe[e] > l0) { l0 = pe[e]; e0 = e; }
            int e1 = -1; float l1 = -__builtin_inff();
#pragma unroll
            for (int e = 0; e < 8; ++e) if (e != e0 && pe[e] > l1) { l1 = pe[e]; e1 = e; }
            const float w0 = 1.0f / (1.0f + __expf(l1 - l0));
            if (lane == 0) { const int tk = F.wave * 8 + i; selE[tk] = e0 | (e1 << 8); selW[2 * tk] = w0; selW[2 * tk + 1] = 1.0f - w0; }
          }
        }
        __syncthreads();
        if (F.wave == 0) {
            const int ee = selE[lane], me0 = ee & 255, me1 = ee >> 8; int r0 = 0, r1 = 0;
            const unsigned long long lt = (1ull << lane) - 1ull;
#pragma unroll
            for (int e = 0; e < 8; ++e) {
                const unsigned long long m0b = __ballot(me0 == e), m1b = __ballot(me1 == e);
                const int c0 = __popcll(m0b), c1 = __popcll(m1b);
                unsigned basee = 0; if (lane == 0) basee = __hip_atomic_fetch_add(F.ctl + CW_CNT + 64 * e, (unsigned)(c0 + c1), __ATOMIC_RELAXED, __HIP_MEMORY_SCOPE_AGENT);
                basee = __builtin_amdgcn_readfirstlane(basee);
                if (me0 == e) r0 = (int)basee + __popcll(m0b & lt);
                if (me1 == e) r1 = (int)basee + c0 + __popcll(m1b & lt);
            }
            selR[2 * lane] = me0 * ECAP + r0; selR[2 * lane + 1] = me1 * ECAP + r1;
            const int tok = grp * 64 + lane;
            F.POSC[2 * tok] = me0 * ECAP + r0; F.POSC[2 * tok + 1] = me1 * ECAP + r1;
            F.GWC[me0 * ECAP + r0] = selW[2 * lane]; F.GWC[me1 * ECAP + r1] = selW[2 * lane + 1];
        }
        __syncthreads();
#pragma unroll 1
        for (int i0 = 0; i0 < 8; i0 += 4) {
          v2u raw[4][8];
#pragma unroll
          for (int r = 0; r < 4; ++r)
#pragma unroll
            for (int j = 0; j < 8; ++j) raw[r][j] = *(const v2u*)(X + (size_t)(m0 + i0 + r) * DM + 4 * lane + 256 * j);
#pragma unroll
          for (int r = 0; r < 4; ++r) { const int i = i0 + r;
            const int tk = F.wave * 8 + i; const int p0 = selR[2 * tk], p1 = selR[2 * tk + 1];
            f32x4 v[8]; float ss = 0.f;
#pragma unroll
            for (int j = 0; j < 8; ++j) { v[j] = unraw(raw[r][j]); ss += (v[j][0] * v[j][0] + v[j][1] * v[j][1]) + (v[j][2] * v[j][2] + v[j][3] * v[j][3]); }
            const float rstd = 1.0f / sqrtf(wave_sum(ss) * (1.0f / DM) + EPS);
            unsigned char* o0 = (unsigned char*)F.HSORT + (size_t)p0 * DM + 4 * lane; unsigned char* o1 = (unsigned char*)F.HSORT + (size_t)p1 * DM + 4 * lane;
#pragma unroll
            for (int j = 0; j < 8; ++j) { const f32x4 hh = v[j] * rstd * a[j] + s[j]; const unsigned o = pg8::cvt4_fp8(hh[0], hh[1], hh[2], hh[3]); *(unsigned*)(o0 + 256 * j) = o; *(unsigned*)(o1 + 256 * j) = o; }
          }
        }
        __syncthreads();
    }
}

__device__ __forceinline__ void moe_setup(Frame& F, pg8::MoeOrder& S, int nN, int a_cap, int b_per_e) {
    int t[8];
#pragma unroll
    for (int e = 0; e < 8; ++e) { const unsigned c = __hip_atomic_load(F.ctl + CW_CNT + 64 * e, __ATOMIC_RELAXED, __HIP_MEMORY_SCOPE_AGENT); t[e] = (int)((c + 255u) >> 8); t[e] = __builtin_amdgcn_readfirstlane(t[e]); }
    S.p1 = t[0]; S.p2 = S.p1 + t[1]; S.p3 = S.p2 + t[2]; S.p4 = S.p3 + t[3]; S.p5 = S.p4 + t[4]; S.p6 = S.p5 + t[5]; S.p7 = S.p6 + t[6]; S.R = S.p7 + t[7];
    if (S.R > MOE_TILES) S.R = MOE_TILES;
    S.nN = nN; S.nwg = S.R * nN; S.G = F.G; S.c = (int)blockIdx.x; S.a_cap = a_cap; S.b_per_e = b_per_e; S.wgm = MK_WGM_MOE; S.xil = (MK_MOE_XIL && F.G == 256 && (32 % MK_WGM_MOE) == 0) ? 1 : 0;
}

__device__ __forceinline__ void phase_combine(Frame& F, const bf16* X, float* out) {
    const int gw = F.vcu * NWAVES + F.wave, NGW = F.G * NWAVES, lane = F.lane;
    int pre[8]; { int acc = 0;
#pragma unroll
        for (int e = 0; e < 8; ++e) { pre[e] = acc; const unsigned c = __hip_atomic_load(F.ctl + CW_CNT + 64 * e, __ATOMIC_RELAXED, __HIP_MEMORY_SCOPE_AGENT); acc += __builtin_amdgcn_readfirstlane((int)((c + 255u) >> 8)); } }
    for (int rb = gw; rb < M / 8; rb += NGW) {
        const int m0 = rb * 8, b = m0 / SEQ;
        const int pcv = F.POSC[2 * m0 + (lane & 15)];
        const float* gf = F.MOD + (size_t)(8 + b) * NMOD + 5 * DM + 4 * lane;
        f32x4 g[8];
#pragma unroll
        for (int j = 0; j < 8; ++j) g[j] = *(const f32x4*)(gf + 256 * j);
        int q[16];
#pragma unroll
        for (int k = 0; k < 16; ++k) { const int pc = __builtin_amdgcn_readlane(pcv, k); const int e = pc >> 14; int bs = 0;
#pragma unroll
            for (int ee = 0; ee < 8; ++ee) bs = (e == ee) ? pre[ee] : bs;
            q[k] = bs * 256 + (pc & 16383); }
        v2u xa[4], ya[4], za[4], xb[4], yb[4], zb[4];
#define CMB_LOAD(st, x_, y_, z_) do { const int i_ = (st) >> 1, c0_ = 1024 * ((st) & 1); const bf16* xp = X + (size_t)(m0 + i_) * DM + 4 * lane + c0_; const int qa_ = q[2 * i_], qb_ = q[2 * i_ + 1]; \
            const bf16* pa_ = F.YP + (size_t)(qa_ < 128 * 256 ? qa_ : 0) * DM + 4 * lane + c0_; const bf16* pb_ = F.YP + (size_t)(qb_ < 128 * 256 ? qb_ : 0) * DM + 4 * lane + c0_; \
            _Pragma("unroll") for (int j = 0; j < 4; ++j) { x_[j] = *(const v2u*)(xp + 256 * j); y_[j] = *(const v2u*)(pa_ + 256 * j); z_[j] = *(const v2u*)(pb_ + 256 * j); } } while (0)
#define CMB_TAIL(qq, c0) do { const float* yt = F.YT + (size_t)((qq) - 128 * 256) * DM + 4 * lane + (c0);              \
            _Pragma("unroll") for (int kc = 0; kc < 4; ++kc) _Pragma("unroll") for (int j = 0; j < 4; ++j) y[j] += *(const f32x4*)(yt + (size_t)kc * (8 * 256) * DM + 256 * j); } while (0)
#define CMB_PROC(st, x_, y_, z_) do { const int i_ = (st) >> 1, c0_ = 1024 * ((st) & 1); const int qa_ = q[2 * i_], qb_ = q[2 * i_ + 1]; float* orow = out + (size_t)(m0 + i_) * DM + 4 * lane + c0_; f32x4 y[4]; \
            _Pragma("unroll") for (int j = 0; j < 4; ++j) y[j] = (f32x4){0.f, 0.f, 0.f, 0.f}; \
            if (qa_ < 128 * 256) { _Pragma("unroll") for (int j = 0; j < 4; ++j) y[j] += unraw(y_[j]); } else CMB_TAIL(qa_, c0_); \
            if (qb_ < 128 * 256) { _Pragma("unroll") for (int j = 0; j < 4; ++j) y[j] += unraw(z_[j]); } else CMB_TAIL(qb_, c0_); \
            _Pragma("unroll") for (int j = 0; j < 4; ++j) *(f32x4*)(orow + 256 * j) = unraw(x_[j]) + g[4 * ((st) & 1) + j] * y[j]; } while (0)
        CMB_LOAD(0, xa, ya, za);
#pragma unroll
        for (int st = 0; st < 16; st += 2) {
            CMB_LOAD(st + 1, xb, yb, zb);
            CMB_PROC(st, xa, ya, za);
            if (st + 2 < 16) CMB_LOAD(st + 2, xa, ya, za);
            CMB_PROC(st + 1, xb, yb, zb);
        }
#undef CMB_LOAD
#undef CMB_TAIL
#undef CMB_PROC
    }
}

__device__ __forceinline__ int lane_id() { int l; asm volatile("v_mbcnt_lo_u32_b32 %0, -1, 0\n\tv_mbcnt_hi_u32_b32 %0, -1, %0" : "=v"(l)); return l; }
__device__ __forceinline__ void fresh_ids(Frame& F) { const int l = lane_id(); F.lane = l; F.wave = F.wave0; F.tid = F.wave0 * 64 + l; }
#ifndef MK_DUP_MASK
#define MK_DUP_MASK 0
#endif
constexpr int NPHASE = 17;
struct Args { const float* in[15]; float* out; unsigned char* ws; int ph_lo, ph_hi; };
__global__ void __launch_bounds__(NWAVES * 64, 2) fwd(Args args) {
    extern __shared__ __attribute__((aligned(16))) unsigned char lds[];
    Frame F;
    F.lds = lds;
    F.wave0 = __builtin_amdgcn_readfirstlane((int)(threadIdx.x >> 6)); fresh_ids(F);
    F.G = gridDim.x; { const int bx = blockIdx.x; F.vcu = (F.G % 8 == 0) ? (bx % 8) * (F.G / 8) + bx / 8 : bx; }
    unsigned char* ws = args.ws;
    F.ctl = (unsigned*)(ws + WS_CTL);
    F.x = args.in[0]; F.c = args.in[1]; F.w_ada = args.in[2]; F.b_ada = args.in[3]; F.attn_norm = args.in[4]; F.ffn_norm = args.in[5]; F.w_qkv = args.in[6]; F.w_o = args.in[7];
    F.qn_q = args.in[8]; F.qn_k = args.in[9]; F.ffn_w_in = args.in[10]; F.ffn_w_out = args.in[11]; F.router_w = args.in[12]; F.moe_w_in = args.in[13]; F.moe_w_out = args.in[14];
    F.out = args.out;
    F.MOD = (float*)(ws + WS_MOD); F.KMEAN = (float*)(ws + WS_KMEAN); F.GWC = (float*)(ws + WS_GWC); F.HSCALE = (float*)(ws + WS_HSCALE); F.WSCFI = (float*)(ws + WS_WSCFI); F.WSCQKV = (float*)(ws + WS_WSCQKV); F.WSCQKV0 = (float*)(ws + WS_WSCQKV + 32768); F.WSCO = (float*)(ws + WS_WSCQKV + 65536); F.POSC = (int*)(ws + WS_POSC);
    F.WQKV = (bf16*)(ws + WS_WQKV); F.WO = (bf16*)(ws + WS_WO); F.WFI = (bf16*)(ws + WS_WFI); F.WFO = (bf16*)(ws + WS_WFO); F.WMI = (bf16*)(ws + WS_WMI); F.WMO = (bf16*)(ws + WS_WMO);
    F.HB = (bf16*)(ws + WS_HB); F.QK = (bf16*)(ws + WS_QKV); F.VT = (bf16*)(ws + WS_QKV + (size_t)M * QKP * 2); F.AO = (bf16*)(ws + WS_AO); F.HID = (bf16*)(ws + WS_HID); F.HSORT = (bf16*)(ws + WS_HSORT); F.HID2 = (bf16*)(ws + WS_HID2); F.YP = (bf16*)(ws + WS_YP); F.YT = (float*)(ws + WS_YT); F.XB = (bf16*)(ws + WS_XB);
    PG8_LAS unsigned char* ldsl = (PG8_LAS unsigned char*)lds;
    for (int u = F.tid; u < (LDS_BYTES - LDSCTL_OFF) / 4; u += NWAVES * 64) ((PG8_LAS unsigned*)(ldsl + LDSCTL_OFF))[u] = 0u;
    __syncthreads();
#if MK_ONE_LAUNCH
    XcdBarrier bar = xcd_barrier_post((unsigned*)(F.ctl + CW_BAR), (volatile LAS unsigned*)(ldsl + MISC_OFF + 32), F.wave0);
#define GRID_BAR() xcd_barrier(bar)
#else
#define GRID_BAR() do { } while (0)
#endif
    const int lo = args.ph_lo, hi = args.ph_hi;
#define IN(k) (lo <= (k) && (k) < hi && (fresh_ids(F), true))
#define SEAM(k) do { if (IN((k) + 1)) GRID_BAR(); } while (0)

    if (IN(0)) { for (int rep_ = 0; rep_ < 1 + ((MK_DUP_MASK >> 0) & 1); ++rep_) { if (rep_) GRID_BAR(); phase_ada(F); } SEAM(0); }
    if (IN(1)) { for (int rep_ = 0; rep_ < 1 + ((MK_DUP_MASK >> 1) & 1); ++rep_) { if (rep_) GRID_BAR(); phase_convert(F); phase_norm<(MK_QKV0_I8 != 0), false>(F, F.x, F.attn_norm, 0, 0, 1, F.HB); } SEAM(1); }
#if !MK_QKV0_I8
    if (IN(2)) { for (int rep_ = 0; rep_ < 1 + ((MK_DUP_MASK >> 2) & 1); ++rep_) { if (rep_) GRID_BAR(); { pg8::Gemm g{F.HB, F.WQKV, M, QKP, DM}; pg8::StaticOrder S; S.init(M, QKP, F.G, (int)blockIdx.x, MK_WGM_QK); pg8::EpiBf16 E{F.QK, QKP};
          pg8::gemm_phase<pg8::EpiBf16, pg8::StaticOrder, true, true>(ldsl + RING_OFF, g, S, E, F.wave0); }
        { pg8::Gemm g{F.WQKV + (size_t)QKP * DM, F.HB, DM, M, DM}; pg8::StaticOrder S; S.init(DM, M, F.G, (int)blockIdx.x, MK_WGM_VT); pg8::EpiBf16 E{F.VT, M};
          pg8::gemm_phase<pg8::EpiBf16, pg8::StaticOrder, true, true>(ldsl + RING_OFF, g, S, E, F.wave0); } } SEAM(2); }
#else
    if (IN(2)) { for (int rep_ = 0; rep_ < 1 + ((MK_DUP_MASK >> 2) & 1); ++rep_) { if (rep_) GRID_BAR();
        { pg8::Gemm g{F.HB, F.WQKV, M, QKP, DM}; pg8::StaticOrder S; S.init(M, QKP, F.G, (int)blockIdx.x, MK_WGM_QK); pg8::EpiBf16i8 E{F.QK, QKP, F.HSCALE, F.WSCQKV0};
          pg8::gemm_phase<pg8::EpiBf16i8, pg8::StaticOrder, true, true, 2>(ldsl + RING_OFF, g, S, E, F.wave0); }
        { pg8::Gemm g{(const bf16*)((const unsigned char*)F.WQKV + (size_t)QKP * DM), F.HB, DM, M, DM}; pg8::StaticOrder S; S.init(DM, M, F.G, (int)blockIdx.x, MK_WGM_VT); pg8::EpiBf16i8 E{F.VT, M, F.WSCQKV0 + QKP, F.HSCALE};
          pg8::gemm_phase<pg8::EpiBf16i8, pg8::StaticOrder, true, true, 2>(ldsl + RING_OFF, g, S, E, F.wave0); } } SEAM(2); }
#endif
    if (IN(3)) { for (int rep_ = 0; rep_ < 1 + ((MK_DUP_MASK >> 3) & 1); ++rep_) { if (rep_) GRID_BAR(); phase_sb(F); } GRID_BAR(); fresh_ids(F); phase_rowq(F, F.AO, (unsigned char*)F.HB); SEAM(3); }
    if (IN(4)) { pg8::Gemm g{F.HB, F.WO, M, DM, DM}; pg8::StaticOrder S; S.init(M, DM, F.G, (int)blockIdx.x, MK_WGM_N8); pg8::EpiResGateBi8<true> E{F.x, F.XB, DM, F.MOD + 2 * DM, NMOD, SEQ, F.HSCALE, F.WSCO};
        pg8::gemm_phase<pg8::EpiResGateBi8<true>, pg8::StaticOrder, true, true, 2>(ldsl + RING_OFF, g, S, E, F.wave0); SEAM(4); }
    if (IN(5)) { for (int rep_ = 0; rep_ < 1 + ((MK_DUP_MASK >> 5) & 1); ++rep_) { if (rep_) GRID_BAR(); phase_norm<true, true>(F, F.XB, F.ffn_norm, 0, 3, 4, F.HB); } SEAM(5); }
    if (IN(6)) { for (int rep_ = 0; rep_ < 1 + ((MK_DUP_MASK >> 6) & 1); ++rep_) { if (rep_) GRID_BAR(); pg8::Gemm g{F.HB, F.WFI, M, 2 * DFF, DM}; pg8::StaticOrder S; S.init(M, 2 * DFF, F.G, (int)blockIdx.x, MK_WGM_FI); pg8::EpiSwiGLUi8f8 E{(unsigned char*)F.HID, DFF, F.HSCALE, F.WSCFI};
        pg8::gemm_phase<pg8::EpiSwiGLUi8f8, pg8::StaticOrder, true, true, 2>(ldsl + RING_OFF, g, S, E, F.wave0); } SEAM(6); }
    if (IN(7)) { pg8::Gemm g{F.HID, F.WFO, M, DM, DFF}; pg8::StaticOrder S; S.init(M, DM, F.G, (int)blockIdx.x, MK_WGM_N8); pg8::EpiResGateB<false> E{F.XB, F.XB, DM, F.MOD + 5 * DM, NMOD, SEQ, 1.0f / 64.0f};
        pg8::gemm_phase<pg8::EpiResGateB<false>, pg8::StaticOrder, true, true, 1>(ldsl + RING_OFF, g, S, E, F.wave0); SEAM(7); }
    if (IN(8)) { phase_norm<(MK_QKV1_I8 != 0), true>(F, F.XB, F.attn_norm + DM, 1, 0, 1, F.HB); SEAM(8); }
#if MK_QKV1_I8
    if (IN(9)) { for (int rep_ = 0; rep_ < 1 + ((MK_DUP_MASK >> 9) & 1); ++rep_) { if (rep_) GRID_BAR();
        const bf16* W1 = F.WQKV + (size_t)NQKV * DM;
        { pg8::Gemm g{F.HB, W1, M, QKP, DM}; pg8::StaticOrder S; S.init(M, QKP, F.G, (int)blockIdx.x, MK_WGM_QK); pg8::EpiBf16i8 E{F.QK, QKP, F.HSCALE, F.WSCQKV};
          pg8::gemm_phase<pg8::EpiBf16i8, pg8::StaticOrder, true, true, 2>(ldsl + RING_OFF, g, S, E, F.wave0); }
        { pg8::Gemm g{(const bf16*)((const unsigned char*)W1 + (size_t)QKP * DM), F.HB, DM, M, DM}; pg8::StaticOrder S; S.init(DM, M, F.G, (int)blockIdx.x, MK_WGM_VT); pg8::EpiBf16i8 E{F.VT, M, F.WSCQKV + QKP, F.HSCALE};
          pg8::gemm_phase<pg8::EpiBf16i8, pg8::StaticOrder, true, true, 2>(ldsl + RING_OFF, g, S, E, F.wave0); } } SEAM(9); }
#else
    if (IN(9)) { for (int rep_ = 0; rep_ < 1 + ((MK_DUP_MASK >> 9) & 1); ++rep_) { if (rep_) GRID_BAR();
        { pg8::Gemm g{F.HB, F.WQKV + (size_t)NQKV * DM, M, QKP, DM}; pg8::StaticOrder S; S.init(M, QKP, F.G, (int)blockIdx.x, MK_WGM_QK); pg8::EpiBf16 E{F.QK, QKP};
          pg8::gemm_phase<pg8::EpiBf16, pg8::StaticOrder, true, true>(ldsl + RING_OFF, g, S, E, F.wave0); }
        { pg8::Gemm g{F.WQKV + (size_t)NQKV * DM + (size_t)QKP * DM, F.HB, DM, M, DM}; pg8::StaticOrder S; S.init(DM, M, F.G, (int)blockIdx.x, MK_WGM_VT); pg8::EpiBf16 E{F.VT, M};
          pg8::gemm_phase<pg8::EpiBf16, pg8::StaticOrder, true, true>(ldsl + RING_OFF, g, S, E, F.wave0); } } SEAM(9); }
#endif
    if (IN(10)) { phase_qknorm(F); SEAM(10); }
    if (IN(11)) { for (int rep_ = 0; rep_ < 1 + ((MK_DUP_MASK >> 11) & 1); ++rep_) { if (rep_) GRID_BAR(); phase_moba(F); } GRID_BAR(); fresh_ids(F); phase_rowq(F, F.AO, (unsigned char*)F.HB); SEAM(11); }
    if (IN(12)) { pg8::Gemm g{F.HB, (const bf16*)((const unsigned char*)F.WO + (size_t)DM * DM), M, DM, DM}; pg8::StaticOrder S; S.init(M, DM, F.G, (int)blockIdx.x, MK_WGM_N8); pg8::EpiResGateBi8<false> E{F.XB, F.XB, DM, F.MOD + (size_t)8 * NMOD + 2 * DM, NMOD, SEQ, F.HSCALE, F.WSCO + DM};
        pg8::gemm_phase<pg8::EpiResGateBi8<false>, pg8::StaticOrder, true, true, 2>(ldsl + RING_OFF, g, S, E, F.wave0); SEAM(12); }
    if (IN(13)) { phase_router(F, F.XB); SEAM(13); }
    if (IN(14)) { for (int rep_ = 0; rep_ < 1 + ((MK_DUP_MASK >> 14) & 1); ++rep_) { if (rep_) GRID_BAR(); pg8::Gemm g{F.HSORT, F.WMI, 0, 0, DM}; pg8::MoeOrder S; moe_setup(F, S, 2 * DFE / 256, ECAP / 256, 2 * DFE / 256); pg8::EpiSwiGLU8 E{(unsigned char*)F.HID2, DFE, 1.0f / 64.0f};
        pg8::gemm_phase<pg8::EpiSwiGLU8, pg8::MoeOrder, true, true, 1>(ldsl + RING_OFF, g, S, E, F.wave0); } SEAM(14); }
    if (IN(15)) { for (int rep_ = 0; rep_ < 1 + ((MK_DUP_MASK >> 15) & 1); ++rep_) { if (rep_) GRID_BAR();
        { pg8::Gemm g{F.HID2, F.WMO, 0, 0, DFE}; pg8::MoeOrder S; moe_setup(F, S, DM / 256, 0, DM / 256); if (S.R > 128) { S.R = 128; S.nwg = 128 * S.nN; }
          pg8::EpiBf16RowScale E{F.YP, DM, F.GWC, 1.0f / 128.0f};
          pg8::gemm_phase<pg8::EpiBf16RowScale, pg8::MoeOrder, true, true, 1>(ldsl + RING_OFF, g, S, E, F.wave0); }
        { pg8::MoeOrder S0; moe_setup(F, S0, DM / 256, 0, DM / 256);
          pg8::MoeTailOrder S; S.G = F.G; S.c = (int)blockIdx.x; S.R = S0.R; S.kchunk = DFE / 4; S.p1 = S0.p1; S.p2 = S0.p2; S.p3 = S0.p3; S.p4 = S0.p4; S.p5 = S0.p5; S.p6 = S0.p6; S.p7 = S0.p7;
          pg8::Gemm g{F.HID2, F.WMO, 0, 0, DFE / 4, DFE}; pg8::EpiF32RowScale E{F.YT, DM, F.GWC, 1.0f / 128.0f};
          pg8::gemm_phase<pg8::EpiF32RowScale, pg8::MoeTailOrder, true, true, 1>(ldsl + RING_OFF, g, S, E, F.wave0); } } SEAM(15); }
    if (IN(16)) { phase_combine(F, F.XB, F.out); }
#undef IN
#undef SEAM
}

extern "C" void kernel_launch(void* const* d_in, const int* in_sizes, int n_in, void* d_out, int out_size, void* d_ws, size_t ws_size, hipStream_t stream) {
    static int grid = 0;
    if (grid == 0) {
        if (n_in != 15 || in_sizes[0] != M * DM || out_size != M * DM || ws_size < WS_END) { fprintf(stderr, "kernel_launch: unexpected shapes (n_in %d, in0 %d, out %d, ws %zu < %zu); nothing launched\n", n_in, n_in > 0 ? in_sizes[0] : -1, out_size, ws_size, (size_t)WS_END); grid = -1; return; }
        int dev = 0, cus = 0, per_cu = 0;
        if (hipGetDevice(&dev) != hipSuccess || hipDeviceGetAttribute(&cus, hipDeviceAttributeMultiprocessorCount, dev) != hipSuccess) { grid = -1; return; }
        if (hipFuncSetAttribute((const void*)fwd, hipFuncAttributeMaxDynamicSharedMemorySize, LDS_BYTES) != hipSuccess) { fprintf(stderr, "kernel_launch: hipFuncSetAttribute failed\n"); grid = -1; return; }
        if (hipOccupancyMaxActiveBlocksPerMultiprocessor(&per_cu, (const void*)fwd, NWAVES * 64, LDS_BYTES) != hipSuccess || per_cu < 1) fprintf(stderr, "kernel_launch: occupancy query reports %d\n", per_cu);
        (void)hipGetLastError();
        grid = cus;
    }
    if (grid < 0) return;
    if (hipMemsetAsync((char*)d_ws + WS_CTL, 0, CTL_ZERO_BYTES, stream) != hipSuccess) { fprintf(stderr, "kernel_launch: memset failed\n"); return; }
    Args a{};
    for (int i = 0; i < 15; ++i) a.in[i] = (const float*)d_in[i];
    a.out = (float*)d_out; a.ws = (unsigned char*)d_ws;
#if MK_ONE_LAUNCH
    a.ph_lo = 0; a.ph_hi = NPHASE;
    hipLaunchKernelGGL(fwd, dim3(grid), dim3(NWAVES * 64), LDS_BYTES, stream, a);
#else
    for (int p = 0; p < NPHASE; ++p) { a.ph_lo = p; a.ph_hi = p + 1; hipLaunchKernelGGL(fwd, dim3(grid), dim3(NWAVES * 64), LDS_BYTES, stream, a); }
#endif
    const hipError_t le = hipPeekAtLastError();
    if (le != hipSuccess) fprintf(stderr, "kernel_launch: launch failed: %s\n", hipGetErrorName(le));
}
```

```cpp
#include <hip/hip_runtime.h>
#include <cstdio>
#include <cstdint>

#ifndef MK_ONE_LAUNCH
#define MK_ONE_LAUNCH 1
#endif

namespace pg8 {
#define PG8_LAS __attribute__((address_space(3)))
typedef unsigned short bf16_t;
typedef short bf16x8 __attribute__((ext_vector_type(8)));
typedef float f32x4 __attribute__((ext_vector_type(4)));
typedef unsigned u32x4 __attribute__((ext_vector_type(4)));
constexpr int BM = 256, BK = 64, HALF = 128, HTB = HALF * BK * 2  , STAGE_BYTES = 8 * HTB, NXCD = 8;

__host__ __device__ __forceinline__ int lds_byte(int r, int c) { const int st = (r >> 4) * 2 + (c >> 5), rr = r & 15, cc = c & 31, ob = rr * 64 + cc * 2; return st * 1024 + (ob ^ (((ob >> 9) & 1) << 5)); }
__host__ __device__ __forceinline__ void stage_rc(int b, int& R, int& C) { const int st = b / 1024, sb = b % 1024, swz = sb ^ (((sb >> 9) & 1) << 5); R = (st >> 1) * 16 + swz / 64; C = (st & 1) * 32 + (swz % 64) / 2; }
__host__ __device__ __forceinline__ int perm32(int rho) { const int n = rho >> 4, i = rho & 15; return 8 * (i >> 2) + 4 * n + (i & 3); }

__device__ __forceinline__ void glds16s(const void* sbase, unsigned voff, unsigned lds_dst) { unsigned keep;
    asm volatile("s_mov_b32 %0, m0\n\ts_mov_b32 m0, %3\n\ts_nop 0\n\tglobal_load_lds_dwordx4 %1, %2\n\ts_mov_b32 m0, %0" : "=&s"(keep) : "v"(voff), "s"(sbase), "s"(lds_dst) : "memory"); }
struct Unit { int pm, pn, om, on, aux, koff; };
typedef int v4i32 __attribute__((ext_vector_type(4))); typedef int v8i32 __attribute__((ext_vector_type(8)));
template <int MODE> struct AccSel { typedef f32x4 T; }; template <> struct AccSel<2> { typedef v4i32 T; };
struct Gemm { const bf16_t* A; const bf16_t* Bt; int M, N, K; int pitch; };

__device__ __forceinline__ void remap_tile(int wgid, int nM, int nN, int nwg, int WGM, int& tm, int& tn) {
    { const int q = nwg / NXCD, r = nwg % NXCD, xcd = wgid % NXCD, off = wgid / NXCD; wgid = (xcd < r ? xcd * (q + 1) : r * (q + 1) + (xcd - r) * q) + off; }
    const int nig = WGM * nN, gid = wgid / nig, fm = gid * WGM, gsz = (nM - fm) < WGM ? (nM - fm) : WGM;
    tm = fm + ((wgid % nig) % gsz); tn = (wgid % nig) / gsz;
}
struct StaticOrder {
    int nM, nN, nwg, G, c, wgm;
    __device__ void init(int M, int N, int G_, int c_, int wgm_ = 4) { nM = M / BM; nN = N / BM; nwg = nM * nN; G = G_; c = c_; wgm = wgm_; }
    __device__ __forceinline__ bool next(int i, Unit& u) const {
        const long L = (long)i * G + c; if (L >= nwg) return false;
        int tm, tn; remap_tile((int)L, nM, nN, nwg, wgm, tm, tn);
        u.pm = tm; u.pn = tn; u.om = tm; u.on = tn; u.aux = 0; u.koff = 0; return true;
    }
    __device__ __forceinline__ void a_ready(const Unit&) const {}
    __device__ __forceinline__ void done(const Unit&) const {}
};
struct MoeOrder {
    int nN, nwg, G, c, R, wgm, xil;
    int p1, p2, p3, p4, p5, p6, p7;
    int a_cap;
    int b_per_e;
    __device__ __forceinline__ bool next(int i, Unit& u) const {
        const long L = (long)i * G + c; if (!xil && L >= nwg) return false;
        int rt, tn;
        if (xil) {
            const int xcd = (int)(L & 7), off = (int)(L >> 3), wg = ((off >> 5) * 8 + xcd) * 32 + (off & 31); if (wg >= nwg) return false;
            const int nig = wgm * nN, gid = wg / nig, fm = gid * wgm, gsz = (R - fm) < wgm ? (R - fm) : wgm; rt = fm + ((wg % nig) % gsz); tn = (wg % nig) / gsz; }
        else remap_tile((int)L, R, nN, nwg, wgm, rt, tn);
        const int e = (rt >= p1) + (rt >= p2) + (rt >= p3) + (rt >= p4) + (rt >= p5) + (rt >= p6) + (rt >= p7);
        int base = 0; base = e >= 1 ? p1 : base; base = e >= 2 ? p2 : base; base = e >= 3 ? p3 : base; base = e >= 4 ? p4 : base; base = e >= 5 ? p5 : base; base = e >= 6 ? p6 : base; base = e >= 7 ? p7 : base;
        const int mt = rt - base;
        u.pm = a_cap ? e * a_cap + mt : rt; u.pn = e * b_per_e + tn; u.om = rt; u.on = tn; u.aux = e * 16384 + mt * 256; u.koff = 0; return true;
    }
    __device__ __forceinline__ void a_ready(const Unit&) const {}
    __device__ __forceinline__ void done(const Unit&) const {}
};

struct MoeTailOrder {
    int G, c, R, kchunk;
    int p1, p2, p3, p4, p5, p6, p7;
    __device__ __forceinline__ bool next(int i, Unit& u) const {
        const int L = i * G + c; if (L >= (R - 128) * 32) return false;
        const int kc = L & 3, tn = (L >> 2) & 7, x = L >> 5, rt = 128 + x;
        const int e = (rt >= p1) + (rt >= p2) + (rt >= p3) + (rt >= p4) + (rt >= p5) + (rt >= p6) + (rt >= p7);
        int base = 0; base = e >= 1 ? p1 : base; base = e >= 2 ? p2 : base; base = e >= 3 ? p3 : base; base = e >= 4 ? p4 : base; base = e >= 5 ? p5 : base; base = e >= 6 ? p6 : base; base = e >= 7 ? p7 : base;
        const int mt = rt - base;
        u.pm = rt; u.pn = e * 8 + tn; u.om = kc * 8 + x; u.on = tn; u.aux = e * 16384 + mt * 256; u.koff = kc * kchunk; return true;
    }
    __device__ __forceinline__ void a_ready(const Unit&) const {}
    __device__ __forceinline__ void done(const Unit&) const {}
};

typedef float f32x2c __attribute__((ext_vector_type(2))); typedef __bf16 bf16x2c __attribute__((ext_vector_type(2)));
__device__ __forceinline__ unsigned cvt_pk_bf16(float lo, float hi) { f32x2c v = {lo, hi}; bf16x2c b = __builtin_convertvector(v, bf16x2c); return __builtin_bit_cast(unsigned, b); }

struct EpiBf16 {
    static constexpr bool PERM = true, AFTER_DRAIN = false;
    bf16_t* O; int ldc;
    __device__ __forceinline__ void operator()(const f32x4 (&acc)[2][2][4][2], const Unit& u, int wr, int wc, int fr, int fq) const {
        const int row0 = u.om * BM + wr * 64 + fr, col0 = u.on * BM + wc * 32 + 8 * fq;
#pragma unroll
        for (int ai = 0; ai < 2; ++ai)
#pragma unroll
            for (int m = 0; m < 4; ++m) { bf16_t* rowp = O + (size_t)(row0 + ai * HALF + m * 16) * ldc + col0;
#pragma unroll
                for (int bj = 0; bj < 2; ++bj) { const f32x4 v0 = acc[ai][bj][m][0], v1 = acc[ai][bj][m][1];
                    u32x4 w; w.x = cvt_pk_bf16(v0[0], v0[1]); w.y = cvt_pk_bf16(v0[2], v0[3]); w.z = cvt_pk_bf16(v1[0], v1[1]); w.w = cvt_pk_bf16(v1[2], v1[3]);
                    *(u32x4*)(rowp + bj * HALF) = w; } }
    }
};
struct EpiBf16RowScale {
    static constexpr bool PERM = true, AFTER_DRAIN = false;
    bf16_t* O; int ldc; const float* rs; float pre;
    __device__ __forceinline__ void operator()(const f32x4 (&acc)[2][2][4][2], const Unit& u, int wr, int wc, int fr, int fq) const {
        const int r0 = wr * 64 + fr, row0 = u.om * BM + r0, col0 = u.on * BM + wc * 32 + 8 * fq;
#pragma unroll
        for (int ai = 0; ai < 2; ++ai)
#pragma unroll
            for (int m = 0; m < 4; ++m) { bf16_t* rowp = O + (size_t)(row0 + ai * HALF + m * 16) * ldc + col0; const float s = rs[u.aux + r0 + ai * HALF + m * 16] * pre;
#pragma unroll
                for (int bj = 0; bj < 2; ++bj) { const f32x4 v0 = acc[ai][bj][m][0] * s, v1 = acc[ai][bj][m][1] * s;
                    u32x4 w; w.x = cvt_pk_bf16(v0[0], v0[1]); w.y = cvt_pk_bf16(v0[2], v0[3]); w.z = cvt_pk_bf16(v1[0], v1[1]); w.w = cvt_pk_bf16(v1[2], v1[3]);
                    *(u32x4*)(rowp + bj * HALF) = w; } }
    }
};
struct EpiF32RowScale {
    static constexpr bool PERM = false, AFTER_DRAIN = false;
    float* C; int ldc; const float* rs; float pre;
    __device__ __forceinline__ void operator()(const f32x4 (&acc)[2][2][4][2], const Unit& u, int wr, int wc, int fr, int fq) const {
        const int r0 = wr * 64 + fr, row0 = u.om * BM + r0, col0 = u.on * BM + wc * 32 + 4 * fq;
#pragma unroll
        for (int ai = 0; ai < 2; ++ai)
#pragma unroll
            for (int m = 0; m < 4; ++m) { float* rowp = C + (size_t)(row0 + ai * HALF + m * 16) * ldc + col0; const float s = rs[u.aux + r0 + ai * HALF + m * 16] * pre;
#pragma unroll
                for (int bj = 0; bj < 2; ++bj)
#pragma unroll
                    for (int n = 0; n < 2; ++n) *(f32x4*)(rowp + bj * HALF + n * 16) = acc[ai][bj][m][n] * s; }
    }
};
struct EpiResGate {
    static constexpr bool PERM = false, AFTER_DRAIN = false;
    const float* resid; float* out; int ldc; const float* gate; int gate_ld; int rows_per_b; float pre;
    __device__ __forceinline__ void operator()(const f32x4 (&acc)[2][2][4][2], const Unit& u, int wr, int wc, int fr, int fq) const {
        const int row0 = u.om * BM + wr * 64 + fr, col0 = u.on * BM + wc * 32 + 4 * fq;
        const float* gp = gate + (size_t)((u.om * BM) / rows_per_b) * gate_ld + col0;
        f32x4 gv[2][2];
#pragma unroll
        for (int bj = 0; bj < 2; ++bj)
#pragma unroll
            for (int n = 0; n < 2; ++n) gv[bj][n] = *(const f32x4*)(gp + bj * HALF + n * 16) * pre;
#pragma unroll
        for (int ai = 0; ai < 2; ++ai)
#pragma unroll
            for (int m = 0; m < 4; ++m) { const size_t off = (size_t)(row0 + ai * HALF + m * 16) * ldc + col0;
#pragma unroll
                for (int bj = 0; bj < 2; ++bj)
#pragma unroll
                    for (int n = 0; n < 2; ++n) { const f32x4 rv = *(const f32x4*)(resid + off + bj * HALF + n * 16); *(f32x4*)(out + off + bj * HALF + n * 16) = rv + gv[bj][n] * acc[ai][bj][m][n]; }
                if (m & 1) asm volatile("" ::: "memory"); }
    }
};
template <bool RESF32> struct EpiResGateB {
    static constexpr bool PERM = true, AFTER_DRAIN = false;
    const void* resid; bf16_t* out; int ldc; const float* gate; int gate_ld; int rows_per_b; float pre;
    __device__ __forceinline__ void operator()(const f32x4 (&acc)[2][2][4][2], const Unit& u, int wr, int wc, int fr, int fq) const {
        const int row0 = u.om * BM + wr * 64 + fr, col0 = u.on * BM + wc * 32 + 8 * fq;
        const float* gp = gate + (size_t)((u.om * BM) / rows_per_b) * gate_ld + col0;
        f32x4 gv[2][2];
#pragma unroll
        for (int bj = 0; bj < 2; ++bj)
#pragma unroll
            for (int n = 0; n < 2; ++n) gv[bj][n] = *(const f32x4*)(gp + bj * HALF + 4 * n) * pre;
#pragma unroll
        for (int ai = 0; ai < 2; ++ai)
#pragma unroll
            for (int m = 0; m < 4; ++m) { const size_t off = (size_t)(row0 + ai * HALF + m * 16) * ldc + col0;
#pragma unroll
                for (int bj = 0; bj < 2; ++bj) { f32x4 r0, r1;
                    if constexpr (RESF32) { r0 = *(const f32x4*)((const float*)resid + off + bj * HALF); r1 = *(const f32x4*)((const float*)resid + off + bj * HALF + 4); }
                    else { const u32x4 rb = *(const u32x4*)((const bf16_t*)resid + off + bj * HALF);
                        r0 = (f32x4){__builtin_bit_cast(float, rb.x << 16), __builtin_bit_cast(float, rb.x & 0xffff0000u), __builtin_bit_cast(float, rb.y << 16), __builtin_bit_cast(float, rb.y & 0xffff0000u)};
                        r1 = (f32x4){__builtin_bit_cast(float, rb.z << 16), __builtin_bit_cast(float, rb.z & 0xffff0000u), __builtin_bit_cast(float, rb.w << 16), __builtin_bit_cast(float, rb.w & 0xffff0000u)}; }
                    const f32x4 v0 = r0 + gv[bj][0] * acc[ai][bj][m][0], v1 = r1 + gv[bj][1] * acc[ai][bj][m][1];
                    u32x4 w; w.x = cvt_pk_bf16(v0[0], v0[1]); w.y = cvt_pk_bf16(v0[2], v0[3]); w.z = cvt_pk_bf16(v1[0], v1[1]); w.w = cvt_pk_bf16(v1[2], v1[3]);
                    *(u32x4*)(out + off + bj * HALF) = w; }
                if (m & 1) asm volatile("" ::: "memory"); }
    }
};
__device__ __forceinline__ unsigned cvt4_fp8(float a, float b, float c, float d) {
    a = __builtin_amdgcn_fmed3f(a, -448.f, 448.f); b = __builtin_amdgcn_fmed3f(b, -448.f, 448.f); c = __builtin_amdgcn_fmed3f(c, -448.f, 448.f); d = __builtin_amdgcn_fmed3f(d, -448.f, 448.f);
    int p = __builtin_amdgcn_cvt_pk_fp8_f32(a, b, 0, false); p = __builtin_amdgcn_cvt_pk_fp8_f32(c, d, p, true); return (unsigned)p; }
struct EpiSwiGLU {
    static constexpr bool PERM = true, AFTER_DRAIN = false;
    bf16_t* O; int ldc; float pre;
    __device__ __forceinline__ static float act(float g, float uu) { return g * uu * __builtin_amdgcn_rcpf(1.0f + __builtin_amdgcn_exp2f(-1.4426950408889634f * g)); }
    __device__ __forceinline__ void operator()(const f32x4 (&acc)[2][2][4][2], const Unit& u, int wr, int wc, int fr, int fq) const {
        const int row0 = u.om * BM + wr * 64 + fr, col0 = u.on * HALF + wc * 32 + 8 * fq;
#pragma unroll
        for (int ai = 0; ai < 2; ++ai)
#pragma unroll
            for (int m = 0; m < 4; ++m) { bf16_t* rowp = O + (size_t)(row0 + ai * HALF + m * 16) * ldc + col0;
                const f32x4 g0 = acc[ai][0][m][0] * pre, g1 = acc[ai][0][m][1] * pre, u0 = acc[ai][1][m][0] * pre, u1 = acc[ai][1][m][1] * pre;
                u32x4 w; w.x = cvt_pk_bf16(act(g0[0], u0[0]), act(g0[1], u0[1])); w.y = cvt_pk_bf16(act(g0[2], u0[2]), act(g0[3], u0[3]));
                w.z = cvt_pk_bf16(act(g1[0], u1[0]), act(g1[1], u1[1])); w.w = cvt_pk_bf16(act(g1[2], u1[2]), act(g1[3], u1[3]));
                *(u32x4*)rowp = w; }
    }
};
__device__ __forceinline__ f32x4 swiglu4p(const f32x4 ag, const f32x4 au, const float npl, const float pp) {
    const f32x4 t = ag * npl;
    f32x4 e; e[0] = __builtin_amdgcn_exp2f(t[0]); e[1] = __builtin_amdgcn_exp2f(t[1]); e[2] = __builtin_amdgcn_exp2f(t[2]); e[3] = __builtin_amdgcn_exp2f(t[3]);
    const f32x4 d = e + 1.0f;
    f32x4 r; r[0] = __builtin_amdgcn_rcpf(d[0]); r[1] = __builtin_amdgcn_rcpf(d[1]); r[2] = __builtin_amdgcn_rcpf(d[2]); r[3] = __builtin_amdgcn_rcpf(d[3]);
    return (ag * au) * (r * pp);
}
struct EpiSwiGLU8 {
    static constexpr bool PERM = true, AFTER_DRAIN = false;
    unsigned char* O; int ldc; float pre;
    __device__ __forceinline__ void operator()(const f32x4 (&acc)[2][2][4][2], const Unit& u, int wr, int wc, int fr, int fq) const {
        const int row0 = u.om * BM + wr * 64 + fr, col0 = u.on * HALF + wc * 32 + 8 * fq;
        const float npl = -1.4426950408889634f * pre, pp = pre * pre;
#pragma unroll
        for (int ai = 0; ai < 2; ++ai)
#pragma unroll
            for (int m = 0; m < 4; ++m) { unsigned char* rowp = O + (size_t)(row0 + ai * HALF + m * 16) * ldc + col0;
                const f32x4 h0 = swiglu4p(acc[ai][0][m][0], acc[ai][1][m][0], npl, pp), h1 = swiglu4p(acc[ai][0][m][1], acc[ai][1][m][1], npl, pp);
                typedef unsigned u32x2e __attribute__((ext_vector_type(2))); u32x2e w;
                w.x = cvt4_fp8(h0[0], h0[1], h0[2], h0[3]); w.y = cvt4_fp8(h1[0], h1[1], h1[2], h1[3]);
                *(u32x2e*)rowp = w; asm volatile("" ::: "memory"); }
    }
};
struct EpiSwiGLUi8 {
    static constexpr bool PERM = true, AFTER_DRAIN = false;
    bf16_t* O; int ldc; const float* rs; const float* cs;
    __device__ __forceinline__ void operator()(const v4i32 (&acc)[2][2][4][2], const Unit& u, int wr, int wc, int fr, int fq) const {
        const int row0 = u.om * BM + wr * 64 + fr, col0 = u.on * HALF + wc * 32 + 8 * fq, cb = u.on * BM + wc * 32 + 8 * fq;
        const f32x4 wg0 = *(const f32x4*)(cs + cb), wg1 = *(const f32x4*)(cs + cb + 4), wu0 = *(const f32x4*)(cs + cb + HALF), wu1 = *(const f32x4*)(cs + cb + HALF + 4);
#pragma unroll
        for (int ai = 0; ai < 2; ++ai)
#pragma unroll
            for (int m = 0; m < 4; ++m) { const int r = row0 + ai * HALF + m * 16; const float hs = rs[r]; bf16_t* rowp = O + (size_t)r * ldc + col0;
                const f32x4 g0 = __builtin_convertvector(acc[ai][0][m][0], f32x4) * (wg0 * hs), g1 = __builtin_convertvector(acc[ai][0][m][1], f32x4) * (wg1 * hs);
                const f32x4 u0 = __builtin_convertvector(acc[ai][1][m][0], f32x4) * (wu0 * hs), u1 = __builtin_convertvector(acc[ai][1][m][1], f32x4) * (wu1 * hs);
                u32x4 w; w.x = cvt_pk_bf16(EpiSwiGLU::act(g0[0], u0[0]), EpiSwiGLU::act(g0[1], u0[1])); w.y = cvt_pk_bf16(EpiSwiGLU::act(g0[2], u0[2]), EpiSwiGLU::act(g0[3], u0[3]));
                w.z = cvt_pk_bf16(EpiSwiGLU::act(g1[0], u1[0]), EpiSwiGLU::act(g1[1], u1[1])); w.w = cvt_pk_bf16(EpiSwiGLU::act(g1[2], u1[2]), EpiSwiGLU::act(g1[3], u1[3]));
                *(u32x4*)rowp = w; asm volatile("" ::: "memory"); }
    }
};
struct EpiSwiGLUi8f8 {
    static constexpr bool PERM = true, AFTER_DRAIN = false;
    unsigned char* O; int ldc; const float* rs; const float* cs;
    __device__ __forceinline__ void operator()(const v4i32 (&acc)[2][2][4][2], const Unit& u, int wr, int wc, int fr, int fq) const {
        const int row0 = u.om * BM + wr * 64 + fr, col0 = u.on * HALF + wc * 32 + 8 * fq, cb = u.on * BM + wc * 32 + 8 * fq;
        const f32x4 wg0 = *(const f32x4*)(cs + cb), wg1 = *(const f32x4*)(cs + cb + 4), wu0 = *(const f32x4*)(cs + cb + HALF), wu1 = *(const f32x4*)(cs + cb + HALF + 4);
#pragma unroll
        for (int ai = 0; ai < 2; ++ai)
#pragma unroll
            for (int m = 0; m < 4; ++m) { const int r = row0 + ai * HALF + m * 16; const float hs = rs[r]; unsigned char* rowp = O + (size_t)r * ldc + col0;
                const f32x4 g0 = __builtin_convertvector(acc[ai][0][m][0], f32x4) * (wg0 * hs), g1 = __builtin_convertvector(acc[ai][0][m][1], f32x4) * (wg1 * hs);
                const f32x4 u0 = __builtin_convertvector(acc[ai][1][m][0], f32x4) * (wu0 * hs), u1 = __builtin_convertvector(acc[ai][1][m][1], f32x4) * (wu1 * hs);
                typedef unsigned u32x2e __attribute__((ext_vector_type(2))); u32x2e w;
                const f32x4 h0 = swiglu4p(g0, u0, -1.4426950408889634f, 1.0f), h1 = swiglu4p(g1, u1, -1.4426950408889634f, 1.0f);
                w.x = cvt4_fp8(h0[0], h0[1], h0[2], h0[3]); w.y = cvt4_fp8(h1[0], h1[1], h1[2], h1[3]);
                *(u32x2e*)rowp = w; asm volatile("" ::: "memory"); }
    }
};
template <bool RESF32> struct EpiResGateBi8 {
    static constexpr bool PERM = true, AFTER_DRAIN = false;
    const void* resid; bf16_t* out; int ldc; const float* gate; int gate_ld; int rows_per_b; const float* rs; const float* cs;
    __device__ __forceinline__ void operator()(const v4i32 (&acc)[2][2][4][2], const Unit& u, int wr, int wc, int fr, int fq) const {
        const int row0 = u.om * BM + wr * 64 + fr, col0 = u.on * BM + wc * 32 + 8 * fq;
        const float* gp = gate + (size_t)((u.om * BM) / rows_per_b) * gate_ld + col0;
        f32x4 gv[2][2];
#pragma unroll
        for (int bj = 0; bj < 2; ++bj)
#pragma unroll
            for (int n = 0; n < 2; ++n) gv[bj][n] = *(const f32x4*)(gp + bj * HALF + 4 * n) * *(const f32x4*)(cs + col0 + bj * HALF + 4 * n);
#pragma unroll
        for (int ai = 0; ai < 2; ++ai)
#pragma unroll
            for (int m = 0; m < 4; ++m) { const int r = row0 + ai * HALF + m * 16; const float hs = rs[r]; const size_t off = (size_t)r * ldc + col0;
#pragma unroll
                for (int bj = 0; bj < 2; ++bj) { f32x4 r0, r1;
                    if constexpr (RESF32) { r0 = *(const f32x4*)((const float*)resid + off + bj * HALF); r1 = *(const f32x4*)((const float*)resid + off + bj * HALF + 4); }
                    else { const u32x4 rb = *(const u32x4*)((const bf16_t*)resid + off + bj * HALF);
                        r0 = (f32x4){__builtin_bit_cast(float, rb.x << 16), __builtin_bit_cast(float, rb.x & 0xffff0000u), __builtin_bit_cast(float, rb.y << 16), __builtin_bit_cast(float, rb.y & 0xffff0000u)};
                        r1 = (f32x4){__builtin_bit_cast(float, rb.z << 16), __builtin_bit_cast(float, rb.z & 0xffff0000u), __builtin_bit_cast(float, rb.w << 16), __builtin_bit_cast(float, rb.w & 0xffff0000u)}; }
                    const f32x4 v0 = r0 + (gv[bj][0] * hs) * __builtin_convertvector(acc[ai][bj][m][0], f32x4), v1 = r1 + (gv[bj][1] * hs) * __builtin_convertvector(acc[ai][bj][m][1], f32x4);
                    u32x4 w; w.x = cvt_pk_bf16(v0[0], v0[1]); w.y = cvt_pk_bf16(v0[2], v0[3]); w.z = cvt_pk_bf16(v1[0], v1[1]); w.w = cvt_pk_bf16(v1[2], v1[3]);
                    *(u32x4*)(out + off + bj * HALF) = w; }
                if (m & 1) asm volatile("" ::: "memory"); }
    }
};
struct EpiBf16i8 {
    static constexpr bool PERM = true, AFTER_DRAIN = false;
    bf16_t* O; int ldc; const float* rs; const float* cs;
    __device__ __forceinline__ void operator()(const v4i32 (&acc)[2][2][4][2], const Unit& u, int wr, int wc, int fr, int fq) const {
        const int row0 = u.om * BM + wr * 64 + fr, col0 = u.on * BM + wc * 32 + 8 * fq;
        f32x4 cv[2][2];
#pragma unroll
        for (int bj = 0; bj < 2; ++bj) { cv[bj][0] = *(const f32x4*)(cs + col0 + bj * HALF); cv[bj][1] = *(const f32x4*)(cs + col0 + bj * HALF + 4); }
#pragma unroll
        for (int ai = 0; ai < 2; ++ai)
#pragma unroll
            for (int m = 0; m < 4; ++m) { const int r = row0 + ai * HALF + m * 16; const float hs = rs[r]; bf16_t* rowp = O + (size_t)r * ldc + col0;
#pragma unroll
                for (int bj = 0; bj < 2; ++bj) { const f32x4 v0 = __builtin_convertvector(acc[ai][bj][m][0], f32x4) * (cv[bj][0] * hs), v1 = __builtin_convertvector(acc[ai][bj][m][1], f32x4) * (cv[bj][1] * hs);
                    u32x4 w; w.x = cvt_pk_bf16(v0[0], v0[1]); w.y = cvt_pk_bf16(v0[2], v0[3]); w.z = cvt_pk_bf16(v1[0], v1[1]); w.w = cvt_pk_bf16(v1[2], v1[3]);
                    *(u32x4*)(rowp + bj * HALF) = w; } }
    }
};

template <class Epi, class Sched, bool ALIGN_EPI = false, bool SP2 = false, int MODE = 0  >
__device__ __forceinline__ void gemm_phase(PG8_LAS unsigned char* lds, const Gemm g, const Sched& S, const Epi& E, const int wave_idx  ) {
    int lane_; asm volatile("v_mbcnt_lo_u32_b32 %0, -1, 0\n\tv_mbcnt_hi_u32_b32 %0, -1, %0" : "=v"(lane_));
    const int wid = wave_idx, lane = lane_, tid = wid * 64 + lane, wr = wid >> 2, wc = wid & 3, fr = lane & 15, fq = lane >> 4;
    const int K = g.K, KB = MODE ? K : 2 * K  , PB = g.pitch ? g.pitch : KB  , nt = KB / (BK * 2);
    unsigned voffA, voffB;
    { int R, C; stage_rc(tid * 16, R, C); const int Rb = Epi::PERM ? ((R & ~31) + perm32(R & 31)) : R;
        voffA = (unsigned)(R * PB + C * 2); voffB = (unsigned)(Rb * PB + C * 2); }
    const size_t rstep = (size_t)64 * PB;
    const size_t kstep = (size_t)(BK * 2);
    const size_t hstep = (size_t)HALF * PB;
    const size_t tstep = 2 * hstep;
    const unsigned ldsw = (unsigned)wid * 1024u; const unsigned ldsb = (unsigned)__builtin_amdgcn_readfirstlane((int)((unsigned)(size_t)lds + ldsw));
    const int aoff = lds_byte(wr * 64 + fr, fq * 8), boff = lds_byte(wc * 32 + fr, fq * 8);
#define PG8_SA(b, h) (((b) * 2 + (h)) * HTB)
#define PG8_SB(b, h) ((4 + (b) * 2 + (h)) * HTB)
#define PG8_STAGE(bufoff, gbase, voff) do { _Pragma("unroll") for (int _i = 0; _i < 2; ++_i) glds16s((const char*)(gbase) + _i * rstep, (voff), ldsb + (unsigned)((bufoff) + _i * 8192)); } while (0)
#define PG8_LDA(dst, b, h) do { if constexpr (MODE == 1) { _Pragma("unroll") for (int m = 0; m < 4; ++m) { const v4i32 l_ = *(const PG8_LAS v4i32*)(lds + PG8_SA(b, h) + aoff + m * 2048), h_ = *(const PG8_LAS v4i32*)(lds + PG8_SA(b, h) + aoff + m * 2048 + 1024); dst##8[m] = __builtin_shufflevector(l_, h_, 0, 1, 2, 3, 4, 5, 6, 7); } } \
        else { _Pragma("unroll") for (int m = 0; m < 4; ++m) _Pragma("unroll") for (int k = 0; k < 2; ++k) dst[m][k] = *(const PG8_LAS bf16x8*)(lds + PG8_SA(b, h) + aoff + m * 2048 + k * 1024); } } while (0)
#define PG8_LDB(dst, b, h) do { if constexpr (MODE == 1) { _Pragma("unroll") for (int n = 0; n < 2; ++n) { const v4i32 l_ = *(const PG8_LAS v4i32*)(lds + PG8_SB(b, h) + boff + n * 2048), h_ = *(const PG8_LAS v4i32*)(lds + PG8_SB(b, h) + boff + n * 2048 + 1024); dst##8[n] = __builtin_shufflevector(l_, h_, 0, 1, 2, 3, 4, 5, 6, 7); } } \
        else { _Pragma("unroll") for (int n = 0; n < 2; ++n) _Pragma("unroll") for (int k = 0; k < 2; ++k) dst[n][k] = *(const PG8_LAS bf16x8*)(lds + PG8_SB(b, h) + boff + n * 2048 + k * 1024); } } while (0)
#define PG8_MMA(ai, bj, At, Bt) do { __builtin_amdgcn_s_setprio(1); _Pragma("unroll") for (int m = 0; m < 4; ++m) _Pragma("unroll") for (int n = 0; n < 2; ++n) { \
        if constexpr (MODE == 1) { acc[ai][bj][m][n] = __builtin_amdgcn_mfma_scale_f32_16x16x128_f8f6f4(Bt##8[n], At##8[m], acc[ai][bj][m][n], 0, 0, 0, 0, 0, 0); }     \
        else if constexpr (MODE == 2) { _Pragma("unroll") for (int k = 0; k < 2; ++k) acc[ai][bj][m][n] = __builtin_amdgcn_mfma_i32_16x16x64_i8(__builtin_bit_cast(v4i32, Bt[n][k]), __builtin_bit_cast(v4i32, At[m][k]), acc[ai][bj][m][n], 0, 0, 0); } \
        else { _Pragma("unroll") for (int k = 0; k < 2; ++k) acc[ai][bj][m][n] = __builtin_amdgcn_mfma_f32_16x16x32_bf16(Bt[n][k], At[m][k], acc[ai][bj][m][n], 0, 0, 0); } } __builtin_amdgcn_s_setprio(0); } while (0)
#define PG8_WAIT_V(n) asm volatile("s_waitcnt vmcnt(" #n ")" ::: "memory")
#define PG8_WAIT_L(n) asm volatile("s_waitcnt lgkmcnt(" #n ")" ::: "memory")
#define PG8_BAR __builtin_amdgcn_s_barrier()
#define PG8_SCHED __builtin_amdgcn_sched_barrier(0)
    Unit cur, nxt; int ui = 0;
    if (!S.next(0, cur)) return;
    typedef typename AccSel<MODE>::T AccT; AccT acc[2][2][4][2];
#pragma unroll
    for (int a = 0; a < 2; ++a)
#pragma unroll
        for (int b = 0; b < 2; ++b)
#pragma unroll
            for (int m = 0; m < 4; ++m)
#pragma unroll
                for (int n = 0; n < 2; ++n) acc[a][b][m][n] = AccT{};
    bf16x8 At[4][2], B0[2][2], B1[2][2]; v8i32 At8[4], B08[2], B18[2];
    const char* cA = (const char*)g.A + (size_t)cur.pm * tstep + cur.koff; const char* cB = (const char*)g.Bt + (size_t)cur.pn * tstep + cur.koff;
    S.a_ready(cur);
    if constexpr (SP2) {
        PG8_STAGE(PG8_SB(0, 0), cB, voffB); PG8_STAGE(PG8_SB(0, 1), cB + hstep, voffB); PG8_STAGE(PG8_SA(0, 0), cA, voffA); PG8_STAGE(PG8_SA(0, 1), cA + hstep, voffA);
        if (wr == 1) PG8_BAR;
        PG8_WAIT_V(2); PG8_BAR;
        PG8_STAGE(PG8_SB(1, 0), cB + kstep, voffB); PG8_STAGE(PG8_SA(1, 0), cA + kstep, voffA); PG8_STAGE(PG8_SB(1, 1), cB + hstep + kstep, voffB);
        PG8_WAIT_V(6); PG8_BAR;
    } else {
        PG8_STAGE(PG8_SB(0, 0), cB, voffB); PG8_STAGE(PG8_SA(0, 0), cA, voffA); PG8_STAGE(PG8_SB(0, 1), cB + hstep, voffB); PG8_STAGE(PG8_SA(0, 1), cA + hstep, voffA);
        if (wr == 1) PG8_BAR;
        PG8_WAIT_V(4); PG8_BAR;
        PG8_STAGE(PG8_SB(1, 0), cB + kstep, voffB); PG8_STAGE(PG8_SA(1, 0), cA + kstep, voffA); PG8_STAGE(PG8_SB(1, 1), cB + hstep + kstep, voffB);
        PG8_WAIT_V(6); PG8_BAR;
    }
    for (;;) {
        const bool has_next = S.next(ui + 1, nxt);
        const char* nA = has_next ? (const char*)g.A + (size_t)nxt.pm * tstep + nxt.koff : cA; const char* nB = has_next ? (const char*)g.Bt + (size_t)nxt.pn * tstep + nxt.koff : cB;
        for (int t = 0; t < nt; t += 2) {
            const bool last = (t == nt - 2);
            const char* a1 = cA + (size_t)(t + 1) * kstep;
            const char* a2 = last ? nA : cA + (size_t)(t + 2) * kstep; const char* b2 = last ? nB : cB + (size_t)(t + 2) * kstep;
            const char* a3 = a2 + kstep; const char* b3 = b2 + kstep;
            if (last && has_next) S.a_ready(nxt);
            if constexpr (SP2) {
            PG8_LDB(B0, 0, 0); PG8_LDB(B1, 0, 1); PG8_SCHED; PG8_LDA(At, 0, 0); PG8_STAGE(PG8_SA(1, 1), a1 + hstep, voffA);
            PG8_WAIT_V(8); PG8_WAIT_L(0); PG8_BAR; PG8_MMA(0, 0, At, B0); PG8_MMA(0, 1, At, B1); PG8_BAR; PG8_SCHED;
            PG8_LDA(At, 0, 1); PG8_STAGE(PG8_SB(0, 0), b2, voffB); PG8_STAGE(PG8_SB(0, 1), b2 + hstep, voffB); PG8_STAGE(PG8_SA(0, 0), a2, voffA);
            PG8_WAIT_V(8); PG8_WAIT_L(0); PG8_BAR; PG8_MMA(1, 0, At, B0); PG8_MMA(1, 1, At, B1); PG8_BAR; PG8_SCHED;
            PG8_LDB(B0, 1, 0); PG8_LDB(B1, 1, 1); PG8_SCHED; PG8_LDA(At, 1, 0); PG8_STAGE(PG8_SA(0, 1), a2 + hstep, voffA);
            PG8_WAIT_V(8); PG8_WAIT_L(0); PG8_BAR; PG8_MMA(0, 0, At, B0); PG8_MMA(0, 1, At, B1); PG8_BAR; PG8_SCHED;
            PG8_LDA(At, 1, 1); PG8_STAGE(PG8_SB(1, 0), b3, voffB); PG8_STAGE(PG8_SB(1, 1), b3 + hstep, voffB); PG8_STAGE(PG8_SA(1, 0), a3, voffA);
            PG8_WAIT_V(8); PG8_WAIT_L(0); PG8_BAR; PG8_MMA(1, 0, At, B0); PG8_MMA(1, 1, At, B1); PG8_BAR; PG8_SCHED;
            } else {
            PG8_LDB(B0, 0, 0); PG8_SCHED; PG8_LDA(At, 0, 0); PG8_STAGE(PG8_SA(1, 1), a1 + hstep, voffA);
            PG8_WAIT_L(8); PG8_BAR; PG8_WAIT_L(0); PG8_MMA(0, 0, At, B0); PG8_BAR; PG8_SCHED;
            PG8_LDB(B1, 0, 1); PG8_STAGE(PG8_SB(0, 0), b2, voffB);
            PG8_BAR; PG8_WAIT_L(0); PG8_MMA(0, 1, At, B1); PG8_BAR;
            PG8_LDA(At, 0, 1); PG8_STAGE(PG8_SA(0, 0), a2, voffA);
            PG8_BAR; PG8_WAIT_L(0); PG8_MMA(1, 0, At, B0); PG8_BAR; PG8_SCHED;
            PG8_STAGE(PG8_SB(0, 1), b2 + hstep, voffB);
            PG8_WAIT_V(6); PG8_BAR; PG8_MMA(1, 1, At, B1); PG8_BAR;
            PG8_LDB(B0, 1, 0); PG8_SCHED; PG8_LDA(At, 1, 0); PG8_STAGE(PG8_SA(0, 1), a2 + hstep, voffA);
            PG8_WAIT_L(8); PG8_BAR; PG8_WAIT_L(0); PG8_MMA(0, 0, At, B0); PG8_BAR; PG8_SCHED;
            PG8_LDB(B1, 1, 1); PG8_STAGE(PG8_SB(1, 0), b3, voffB);
            PG8_BAR; PG8_WAIT_L(0); PG8_MMA(0, 1, At, B1); PG8_BAR;
            PG8_LDA(At, 1, 1); PG8_STAGE(PG8_SA(1, 0), a3, voffA);
            PG8_BAR; PG8_WAIT_L(0); PG8_MMA(1, 0, At, B0); PG8_BAR; PG8_SCHED;
            PG8_STAGE(PG8_SB(1, 1), b3 + hstep, voffB);
            PG8_WAIT_V(6); PG8_BAR; PG8_MMA(1, 1, At, B1); PG8_BAR;
            }
        }
        if constexpr (ALIGN_EPI) { if (wr == 0) PG8_BAR; }
        if constexpr (!Epi::AFTER_DRAIN) { E(acc, cur, wr, wc, fr, fq); S.done(cur); }
        if (!has_next) break;
#pragma unroll
        for (int a = 0; a < 2; ++a)
#pragma unroll
            for (int b = 0; b < 2; ++b)
#pragma unroll
                for (int m = 0; m < 4; ++m)
#pragma unroll
                    for (int n = 0; n < 2; ++n) acc[a][b][m][n] = AccT{};
        cur = nxt; cA = nA; cB = nB; ++ui;
        if constexpr (ALIGN_EPI) { if (wr == 1) PG8_BAR; }
    }
    PG8_WAIT_V(0);
    if constexpr (!ALIGN_EPI) { if (wr == 0) PG8_BAR; }
    PG8_BAR;
    if constexpr (Epi::AFTER_DRAIN) { E.fused(acc, cur, wr, wc, fr, fq, lds, wid, lane); S.done(cur); }
#undef PG8_SA
#undef PG8_SB
#undef PG8_STAGE
#undef PG8_LDA
#undef PG8_LDB
#undef PG8_MMA
#undef PG8_WAIT_V
#undef PG8_WAIT_L
#undef PG8_BAR
#undef PG8_SCHED
}
}

#ifndef MK_MOE_XIL
#define MK_MOE_XIL 1
#endif

#ifndef MK_WGM_QK
#define MK_WGM_QK 4
#endif
#ifndef MK_WGM_VT
#define MK_WGM_VT 4
#endif
#ifndef MK_WGM_N8
#define MK_WGM_N8 4
#endif
#ifndef MK_WGM_FI
#define MK_WGM_FI 4
#endif

#ifndef MK_WGM_MOE
#define MK_WGM_MOE 4
#endif

#ifndef MK_QKV0_I8
#define MK_QKV0_I8 1
#endif
#ifndef MK_QKV1_I8
#define MK_QKV1_I8 1
#endif

constexpr int NWAVES = 8;
constexpr int DM = 2048, NB = 8, SEQ = 2048, M = NB * SEQ, NH = 16, HD = 128, DFF = 5632, NE = 8, DFE = 7168, NQKV = 3 * DM, NMOD = 6 * DM;
constexpr int ECAP = 16384;
constexpr int MOE_TILES = 136;
constexpr float EPS = 1e-6f;
constexpr float ATT_SCALE = 0.08838834764831845f;
constexpr float LOG2E = 1.4426950408889634f;

constexpr size_t MiB = 1u << 20;
constexpr size_t WS_CTL = 0, CTL_ZERO_BYTES = 1 * MiB;
constexpr size_t WS_MOD = 1 * MiB;
constexpr size_t WS_KMEAN = 2 * MiB;
constexpr size_t WS_POSC = 3 * MiB;
constexpr size_t WS_GWC = 4 * MiB;
constexpr size_t WS_HSCALE = 5 * MiB;
constexpr size_t WS_WSCFI = 6 * MiB;
constexpr size_t WS_WSCQKV = 7 * MiB;
constexpr size_t WS_WQKV = 8 * MiB;
constexpr size_t WS_WO = 56 * MiB;
constexpr size_t WS_WFI = 72 * MiB;
constexpr size_t WS_WFO = 116 * MiB;
constexpr size_t WS_WMI = 138 * MiB;
constexpr size_t WS_WMO = 586 * MiB;
constexpr size_t WS_HB = 810 * MiB;
constexpr size_t WS_QKV = 874 * MiB;
constexpr size_t WS_AO = 1066 * MiB;
constexpr size_t WS_HID = 1130 * MiB;
constexpr size_t WS_HSORT = 1306 * MiB;
constexpr size_t WS_HID2 = 1818 * MiB;
constexpr size_t WS_YP = 2294 * MiB;
constexpr size_t WS_YT = 2430 * MiB;
constexpr size_t WS_XB = 2494 * MiB;
constexpr size_t WS_END = 2558 * MiB;
static_assert(WS_WQKV + 2ull * NQKV * DM * 2 <= WS_WO && WS_WO + 2ull * DM * DM * 2 <= WS_WFI && WS_WFI + 2ull * DFF * DM * 2 <= WS_WFO && WS_WFO + (size_t)DM * DFF * 2 <= WS_WMI, "ws map 1");
static_assert(WS_WMI + 8ull * 2 * DFE * DM * 2 <= WS_WMO && WS_WMO + 8ull * DM * DFE * 2 <= WS_HB && WS_HB + (size_t)M * DM * 2 <= WS_QKV && WS_QKV + (size_t)M * NQKV * 2 <= WS_AO, "ws map 2");
static_assert(WS_AO + (size_t)M * DM * 2 <= WS_HID && WS_HID + (size_t)M * DFF * 2 <= WS_HSORT && WS_HSORT + 8ull * ECAP * DM * 2 <= WS_HID2 && WS_HID2 + (size_t)MOE_TILES * 256 * DFE * 2 <= WS_YP && WS_YP + (size_t)MOE_TILES * 256 * DM * 2 <= WS_YT && WS_YT + 4ull * 8 * 256 * DM * 4 <= WS_XB && WS_XB + (size_t)M * DM * 2 <= WS_END, "ws map 3");
constexpr int CW_TMO = 0;
constexpr int CW_CNT = 1024;
constexpr int CW_BAR = 4096;

constexpr int RING_OFF = 0, RING_BYTES = 131072;
constexpr int LDSCTL_OFF = 141312  , MISC_OFF = LDSCTL_OFF + 320;
constexpr int LDS_BYTES = 147456;

#define LAS __attribute__((address_space(3)))
typedef unsigned short bf16;
typedef float f32x4 __attribute__((ext_vector_type(4)));
typedef unsigned v4u __attribute__((ext_vector_type(4)));
typedef unsigned v2u __attribute__((ext_vector_type(2)));
#define LDS_WAIT() asm volatile("s_waitcnt lgkmcnt(0)" ::: "memory")
__device__ __forceinline__ unsigned f2bf(float f) { unsigned u = __builtin_bit_cast(unsigned, f); return (u + 0x7fffu + ((u >> 16) & 1u)) >> 16; }
__device__ __forceinline__ unsigned pk2(float lo, float hi) { return f2bf(lo) | (f2bf(hi) << 16); }
__device__ __forceinline__ float bflo(unsigned u) { return __builtin_bit_cast(float, u << 16); }
__device__ __forceinline__ float bfhi(unsigned u) { return __builtin_bit_cast(float, u & 0xffff0000u); }
__device__ __forceinline__ float rdlane(float v, int l) { return __builtin_bit_cast(float, __builtin_amdgcn_readlane(__builtin_bit_cast(int, v), l)); }
template <int CTRL> __device__ __forceinline__ float dppf(float v) { return __builtin_bit_cast(float, __builtin_amdgcn_update_dpp(0, __builtin_bit_cast(int, v), CTRL, 0xF, 0xF, true)); }
__device__ __forceinline__ float wave_sum(float v) {
    v += dppf<0xB1>(v); v += dppf<0x4E>(v); v += dppf<0x141>(v); v += dppf<0x140>(v);
    return (rdlane(v, 0) + rdlane(v, 16)) + (rdlane(v, 32) + rdlane(v, 48));
}
__device__ __forceinline__ float wave_max(float v) {
    v = fmaxf(v, dppf<0xB1>(v)); v = fmaxf(v, dppf<0x4E>(v)); v = fmaxf(v, dppf<0x141>(v)); v = fmaxf(v, dppf<0x140>(v));
    return fmaxf(fmaxf(rdlane(v, 0), rdlane(v, 16)), fmaxf(rdlane(v, 32), rdlane(v, 48)));
}

#define XB_TMO      128
#define XB_XCNT(j)  (256  + 64 * (j))
#define XB_XSUB(j)  (1280 + 64 * (j))
#define XB_XGEN(j)  (2304 + 64 * (j))
#define XB_TOP      3328
#define XB_TOPGEN   3392
#define XCD_BAR_WORDS 3456
#define XB_SPIN_CAP (1u << 20)
__device__ __forceinline__ unsigned xb_ld(unsigned* p)              { return __hip_atomic_load(p, __ATOMIC_RELAXED, __HIP_MEMORY_SCOPE_AGENT); }
__device__ __forceinline__ unsigned xb_add(unsigned* p, unsigned v) { return __hip_atomic_fetch_add(p, v, __ATOMIC_RELAXED, __HIP_MEMORY_SCOPE_AGENT); }
__device__ __forceinline__ unsigned xb_xcc_id() { return (unsigned)__builtin_amdgcn_s_getreg((3 << 11) | 20) & 0xFu; }
#define XB_SPIN(cond, bar) do { unsigned _sp = 0; while (cond) { __builtin_amdgcn_s_sleep(1); \
    if ((++_sp & 255u) == 0u) { if (xb_ld(&(bar)[XB_TMO])) break; if (_sp > XB_SPIN_CAP) { atomicAdd(&(bar)[XB_TMO], 1u); break; } } } } while (0)
struct XcdBarrier { unsigned* bar; unsigned x; volatile LAS unsigned* st; int wave; };
__device__ __forceinline__ int lane_id();
__device__ __forceinline__ bool xb_leader(int wave) { return wave == 0 && lane_id() == 0; }
__device__ __forceinline__ XcdBarrier xcd_barrier_post(unsigned* bar, volatile LAS unsigned* st, int wave) {
    XcdBarrier b; b.bar = bar; b.x = xb_xcc_id(); b.st = st; b.wave = wave;
    if (xb_leader(wave)) (void)xb_add(&bar[XB_XCNT(b.x)], 1u);
    return b;
}
__device__ __forceinline__ void xcd_barrier_complete(unsigned* bar, unsigned x, unsigned& nloc, unsigned& nx) {
    const unsigned G = gridDim.x * gridDim.y * gridDim.z;
    unsigned sum, cnt, mine, sp = 0u;
    for (;;) {
        sum = 0u; cnt = 0u; mine = 0u;
#pragma unroll
        for (unsigned j = 0; j < 16; ++j) { const unsigned c = xb_ld(&bar[XB_XCNT(j)]); sum += c; cnt += (c > 0u) ? 1u : 0u; mine = (j == x) ? c : mine; }
        if (sum == G) break;
        __builtin_amdgcn_s_sleep(1);
        if ((++sp & 255u) == 0u) { if (xb_ld(&bar[XB_TMO])) break; if (sp > XB_SPIN_CAP) { atomicAdd(&bar[XB_TMO], 1u); break; } }
    }
    nloc = mine > 0u ? mine : 1u; nx = cnt > 0u ? cnt : 1u;
}
__device__ __forceinline__ void xcd_barrier(const XcdBarrier& b) {
    asm volatile("s_waitcnt vmcnt(0)" ::: "memory");
    __syncthreads();
    if (xb_leader(b.wave)) {
        unsigned* bar = b.bar;
        __builtin_amdgcn_s_waitcnt(0);
        unsigned nloc = b.st[0], nx = b.st[1];
        if (nloc == 0u) { xcd_barrier_complete(bar, b.x, nloc, nx); b.st[0] = nloc; b.st[1] = nx; }
        const unsigned old = xb_add(&bar[XB_XSUB(b.x)], 1u);
        const unsigned gen = old / nloc;
        if (old + 1u == (gen + 1u) * nloc) {
            __builtin_amdgcn_fence(__ATOMIC_RELEASE, "agent");
            asm volatile("s_waitcnt vmcnt(0)" ::: "memory");
            const unsigned og = xb_add(&bar[XB_TOP], 1u);
            const unsigned tg = og / nx;
            if (og + 1u == (tg + 1u) * nx) xb_add(&bar[XB_TOPGEN], 1u);
            else XB_SPIN(xb_ld(&bar[XB_TOPGEN]) == tg, bar);
            __builtin_amdgcn_fence(__ATOMIC_ACQUIRE, "agent");
            xb_add(&bar[XB_XGEN(b.x)], 1u);
            asm volatile("s_waitcnt vmcnt(0)" ::: "memory");
        } else {
            XB_SPIN(xb_ld(&bar[XB_XGEN(b.x)]) == gen, bar);
            __builtin_amdgcn_fence(__ATOMIC_ACQUIRE, "agent");
            asm volatile("s_waitcnt vmcnt(0)" ::: "memory");
        }
    }
    __syncthreads();
}

struct Frame {
    unsigned char* lds;
    unsigned* ctl;
    int tid, lane, wave, wave0, vcu, G;
    const float *x, *c, *w_ada, *b_ada, *attn_norm, *ffn_norm, *w_qkv, *w_o, *qn_q, *qn_k, *ffn_w_in, *ffn_w_out, *router_w, *moe_w_in, *moe_w_out;
    float* out;
    float *MOD, *KMEAN, *GWC, *HSCALE, *WSCFI, *WSCQKV, *WSCQKV0, *WSCO, *YT; int* POSC;
    bf16 *WQKV, *WO, *WFI, *WFO, *WMI, *WMO, *HB, *QK, *VT, *AO, *XB, *HID, *HSORT, *HID2, *YP;
};

__device__ __forceinline__ void phase_ada(Frame& F) {
    float* cs = (float*)(F.lds);
    float* red = (float*)(F.lds + 65536);
    for (int i = F.tid; i < NB * DM; i += NWAVES * 64) { const int b = i / DM, k = i % DM; cs[k * 8 + b] = F.c[i]; }
    __syncthreads();
    const int cq = F.tid % 24, kg = F.tid / 24;
    for (int u = blockIdx.x; u < 256; u += F.G) {
        const int l = u >> 7, col0 = (u & 127) * 96;
        f32x4 acc[8];
#pragma unroll
        for (int b = 0; b < 8; ++b) acc[b] = (f32x4){0.f, 0.f, 0.f, 0.f};
        if (kg < 21) {
            const float* wp = F.w_ada + (size_t)l * DM * NMOD + col0 + cq * 4;
#pragma unroll 4
            for (int k = kg; k < DM; k += 21) {
                const f32x4 w = *(const f32x4*)(wp + (size_t)k * NMOD);
                const f32x4 c0 = *(const f32x4*)(cs + k * 8), c1 = *(const f32x4*)(cs + k * 8 + 4);
                acc[0] += w * c0[0]; acc[1] += w * c0[1]; acc[2] += w * c0[2]; acc[3] += w * c0[3];
                acc[4] += w * c1[0]; acc[5] += w * c1[1]; acc[6] += w * c1[2]; acc[7] += w * c1[3];
            }
#pragma unroll
            for (int b = 0; b < 8; ++b) *(f32x4*)(red + (kg * 8 + b) * 96 + cq * 4) = acc[b];
        }
        __syncthreads();
        for (int o = F.tid; o < 8 * 96; o += NWAVES * 64) { const int b = o / 96, cc = o % 96; float s = F.b_ada[l * NMOD + col0 + cc];
            for (int g = 0; g < 21; ++g) s += red[(g * 8 + b) * 96 + cc];
            F.MOD[(size_t)(l * 8 + b) * NMOD + col0 + cc] = s; }
        __syncthreads();
    }
}

__device__ __forceinline__ void transpose_item(const float* W, int K, int N, bf16* WT, int ilv, float* scr, int item, int lane) {
    const int nblk = N / 32, kb = item / nblk, nb = item % nblk, k0 = 64 * kb, n0 = 32 * nb;
    int row0 = n0;
    if (ilv) { const int up = n0 >= ilv, j0 = n0 - (up ? ilv : 0); row0 = (j0 >> 7) * 256 + (up ? 128 : 0) + (j0 & 127); }
#pragma unroll 16
    for (int i = 0; i < 32; ++i) { const int kk = 2 * i + (lane >> 5); scr[kk * 33 + (lane & 31)] = __builtin_nontemporal_load(W + (size_t)(k0 + kk) * N + n0 + (lane & 31)); }
    LDS_WAIT(); asm volatile("" ::: "memory");
    const int c = lane & 7;
#pragma unroll
    for (int j = 0; j < 4; ++j) { const int n = (lane >> 3) + 8 * j; const float* s = scr + (8 * c) * 33 + n;
        v4u o; o.x = pk2(s[0 * 33], s[1 * 33]); o.y = pk2(s[2 * 33], s[3 * 33]); o.z = pk2(s[4 * 33], s[5 * 33]); o.w = pk2(s[6 * 33], s[7 * 33]);
        *(v4u*)(WT + (size_t)(row0 + n) * K + k0 + 8 * c) = o; }
    LDS_WAIT(); asm volatile("" ::: "memory");
}
__device__ __forceinline__ int ilv_row(int n, int ilv) { if (!ilv) return n; const int up = n >= ilv, j = n - (up ? ilv : 0); return (j >> 7) * 256 + (up ? 128 : 0) + (j & 127); }
__device__ __forceinline__ void colscale_unit(Frame& F, const float* W, int K, int N, int ilv, float* scale, int unit) {
    float* red = (float*)F.lds;
    const int cq = F.tid & 15, kg = F.tid >> 4, col0 = unit * 64 + cq * 4;
    f32x4 mx = {0.f, 0.f, 0.f, 0.f};
#pragma unroll 4
    for (int k = kg; k < K; k += 32) { const f32x4 w = *(const f32x4*)(W + (size_t)k * N + col0); mx[0] = fmaxf(mx[0], fabsf(w[0])); mx[1] = fmaxf(mx[1], fabsf(w[1])); mx[2] = fmaxf(mx[2], fabsf(w[2])); mx[3] = fmaxf(mx[3], fabsf(w[3])); }
    *(f32x4*)(red + kg * 64 + cq * 4) = mx;
    __syncthreads();
    if (F.tid < 64) { float m = 0.f;
#pragma unroll
        for (int g = 0; g < 32; ++g) m = fmaxf(m, red[g * 64 + F.tid]);
        scale[ilv_row(unit * 64 + F.tid, ilv)] = fmaxf(m, 1e-30f) * (1.0f / 127.0f); }
    __syncthreads();
}
__device__ __forceinline__ void phase_colscale(Frame& F) {
    constexpr int U_FI = 2 * DFF / 64, U_Q = NQKV / 64, U_Q0 = MK_QKV0_I8 ? NQKV / 64 : 0;
    for (int u = blockIdx.x; u < U_FI + U_Q + U_Q0; u += F.G) {
        if (u < U_FI) colscale_unit(F, F.ffn_w_in, DM, 2 * DFF, DFF, F.WSCFI, u);
        else if (u < U_FI + U_Q) colscale_unit(F, F.w_qkv + (size_t)DM * NQKV, DM, NQKV, 0, F.WSCQKV, u - U_FI);
        else colscale_unit(F, F.w_qkv, DM, NQKV, 0, F.WSCQKV0, u - U_FI - U_Q);
    }
}
__device__ __forceinline__ unsigned pack4_i8_nc(float a, float b, float c, float d) {
    const float MG = 12582912.0f;
    const unsigned ua = __builtin_bit_cast(unsigned, a + MG), ub = __builtin_bit_cast(unsigned, b + MG), uc = __builtin_bit_cast(unsigned, c + MG), ud = __builtin_bit_cast(unsigned, d + MG);
    return __builtin_amdgcn_perm(ub, ua, 0x0c0c0400u) | __builtin_amdgcn_perm(ud, uc, 0x04000c0cu); }
__device__ __forceinline__ unsigned pack4_i8(float a, float b, float c, float d) {
    return pack4_i8_nc(__builtin_amdgcn_fmed3f(a, -127.f, 127.f), __builtin_amdgcn_fmed3f(b, -127.f, 127.f), __builtin_amdgcn_fmed3f(c, -127.f, 127.f), __builtin_amdgcn_fmed3f(d, -127.f, 127.f)); }
__device__ __forceinline__ void transpose_item_i8(const float* W, int K, int N, unsigned char* WT, int ilv, const float* scale, float* scr, int item, int lane) {
    const int nblk = N / 32, kb = item / nblk, nb = item % nblk, k0 = 128 * kb, n0 = 32 * nb;
    const int row0 = ilv_row(n0, ilv);
#pragma unroll 16
    for (int i = 0; i < 64; ++i) { const int kk = 2 * i + (lane >> 5); scr[kk * 33 + (lane & 31)] = __builtin_nontemporal_load(W + (size_t)(k0 + kk) * N + n0 + (lane & 31)); }
    LDS_WAIT(); asm volatile("" ::: "memory");
    const int c = lane & 7;
#pragma unroll
    for (int j = 0; j < 4; ++j) { const int n = (lane >> 3) + 8 * j; const float* s = scr + (16 * c) * 33 + n; const float inv = 1.0f / scale[row0 + n];
        v4u o; o.x = pack4_i8(s[0 * 33] * inv, s[1 * 33] * inv, s[2 * 33] * inv, s[3 * 33] * inv); o.y = pack4_i8(s[4 * 33] * inv, s[5 * 33] * inv, s[6 * 33] * inv, s[7 * 33] * inv);
        o.z = pack4_i8(s[8 * 33] * inv, s[9 * 33] * inv, s[10 * 33] * inv, s[11 * 33] * inv); o.w = pack4_i8(s[12 * 33] * inv, s[13 * 33] * inv, s[14 * 33] * inv, s[15 * 33] * inv);
        *(v4u*)(WT + (size_t)(row0 + n) * K + k0 + 16 * c) = o; }
    LDS_WAIT(); asm volatile("" ::: "memory");
}
__device__ __forceinline__ void transpose_item_f8(const float* W, int K, int N, unsigned char* WT, int ilv, float mult, float* scr, int item, int lane) {
    const int nblk = N / 32, kb = item / nblk, nb = item % nblk, k0 = 128 * kb, n0 = 32 * nb;
    int row0 = n0;
    if (ilv) { const int up = n0 >= ilv, j0 = n0 - (up ? ilv : 0); row0 = (j0 >> 7) * 256 + (up ? 128 : 0) + (j0 & 127); }
#pragma unroll 16
    for (int i = 0; i < 64; ++i) { const int kk = 2 * i + (lane >> 5); scr[kk * 33 + (lane & 31)] = __builtin_nontemporal_load(W + (size_t)(k0 + kk) * N + n0 + (lane & 31)); }
    LDS_WAIT(); asm volatile("" ::: "memory");
    const int c = lane & 7;
#pragma unroll
    for (int j = 0; j < 4; ++j) { const int n = (lane >> 3) + 8 * j; const float* s = scr + (16 * c) * 33 + n;
        v4u o; o.x = pg8::cvt4_fp8(s[0 * 33] * mult, s[1 * 33] * mult, s[2 * 33] * mult, s[3 * 33] * mult); o.y = pg8::cvt4_fp8(s[4 * 33] * mult, s[5 * 33] * mult, s[6 * 33] * mult, s[7 * 33] * mult);
        o.z = pg8::cvt4_fp8(s[8 * 33] * mult, s[9 * 33] * mult, s[10 * 33] * mult, s[11 * 33] * mult); o.w = pg8::cvt4_fp8(s[12 * 33] * mult, s[13 * 33] * mult, s[14 * 33] * mult, s[15 * 33] * mult);
        *(v4u*)(WT + (size_t)(row0 + n) * K + k0 + 16 * c) = o; }
    LDS_WAIT(); asm volatile("" ::: "memory");
}
__device__ __forceinline__ void i8_slab(Frame& F, const float* W, int N, unsigned char* WT, int ilv, float* scale, int slab) {
    constexpr int PITCH = 4112;
    unsigned char* T = F.lds; float* cmx = (float*)(F.lds + 32 * PITCH);
    const int lane = F.lane, w = F.wave, c4 = lane & 7, kr = lane >> 3, n0 = 32 * slab, row0 = ilv_row(n0, ilv);
    { const float* src = W + (size_t)(256 * w + 32 * kr) * N + n0 + 4 * c4;
      f32x4 v[32];
#pragma unroll
      for (int i = 0; i < 32; ++i) v[i] = __builtin_nontemporal_load((const f32x4*)(src + (size_t)i * N));
      f32x4 mx = {0.f, 0.f, 0.f, 0.f};
#pragma unroll
      for (int i = 0; i < 32; ++i) { mx[0] = fmaxf(mx[0], fabsf(v[i][0])); mx[1] = fmaxf(mx[1], fabsf(v[i][1])); mx[2] = fmaxf(mx[2], fabsf(v[i][2])); mx[3] = fmaxf(mx[3], fabsf(v[i][3])); }
#pragma unroll
      for (int e = 0; e < 4; ++e) { unsigned char* dst = T + (8 * e + c4) * PITCH + 2 * (256 * w + 32 * kr);
#pragma unroll
          for (int qd = 0; qd < 4; ++qd) { v4u o; o.x = pk2(v[8 * qd + 0][e], v[8 * qd + 1][e]); o.y = pk2(v[8 * qd + 2][e], v[8 * qd + 3][e]); o.z = pk2(v[8 * qd + 4][e], v[8 * qd + 5][e]); o.w = pk2(v[8 * qd + 6][e], v[8 * qd + 7][e]);
              *(v4u*)(dst + 16 * qd) = o; } }
#pragma unroll
      for (int e = 0; e < 4; ++e) { mx[e] = fmaxf(mx[e], __shfl_xor(mx[e], 8)); mx[e] = fmaxf(mx[e], __shfl_xor(mx[e], 16)); mx[e] = fmaxf(mx[e], __shfl_xor(mx[e], 32)); }
      if (kr == 0) *(f32x4*)(cmx + w * 32 + 4 * c4) = mx; }
    __syncthreads();
    { const int n = F.tid >> 4, kc = F.tid & 15;
      float m = 0.f;
#pragma unroll
      for (int ww = 0; ww < 8; ++ww) m = fmaxf(m, cmx[ww * 32 + n]);
      const float sc = fmaxf(m, 1e-30f) * (1.0f / 127.0f), inv = 1.0f / sc;
      if (kc == 0) scale[row0 + n] = sc;
      const unsigned char* srow = T + (8 * (n & 3) + (n >> 2)) * PITCH + 32 * kc; unsigned char* drow = WT + (size_t)(row0 + n) * DM + 16 * kc;
#pragma unroll
      for (int j = 0; j < 8; ++j) { const v4u a = *(const v4u*)(srow + 512 * j), b = *(const v4u*)(srow + 512 * j + 16);
          v4u o; o.x = pack4_i8(bflo(a.x) * inv, bfhi(a.x) * inv, bflo(a.y) * inv, bfhi(a.y) * inv); o.y = pack4_i8(bflo(a.z) * inv, bfhi(a.z) * inv, bflo(a.w) * inv, bfhi(a.w) * inv);
          o.z = pack4_i8(bflo(b.x) * inv, bfhi(b.x) * inv, bflo(b.y) * inv, bfhi(b.y) * inv); o.w = pack4_i8(bflo(b.z) * inv, bfhi(b.z) * inv, bflo(b.w) * inv, bfhi(b.w) * inv);
          *(v4u*)(drow + 256 * j) = o; } }
    __syncthreads();
}
constexpr int CW_Q = 8192;
__device__ __forceinline__ void phase_convert(Frame& F) {
    static_assert(MK_QKV0_I8 && MK_QKV1_I8, "the int8 slabs below cover both QKV projections");
    { constexpr int S_Q = NQKV / 32, S_FI = 2 * DFF / 32, S_O = DM / 32;
      for (int u = blockIdx.x; u < 2 * S_Q + S_FI + 2 * S_O; u += F.G) {
          if (u < S_Q) i8_slab(F, F.w_qkv, NQKV, (unsigned char*)F.WQKV, 0, F.WSCQKV0, u);
          else if (u < 2 * S_Q) i8_slab(F, F.w_qkv + (size_t)DM * NQKV, NQKV, (unsigned char*)(F.WQKV + (size_t)NQKV * DM), 0, F.WSCQKV, u - S_Q);
          else if (u < 2 * S_Q + S_FI) i8_slab(F, F.ffn_w_in, 2 * DFF, (unsigned char*)F.WFI, DFF, F.WSCFI, u - 2 * S_Q);
          else { const int v = u - 2 * S_Q - S_FI, l = v / S_O; i8_slab(F, F.w_o + (size_t)l * DM * DM, DM, (unsigned char*)F.WO + (size_t)l * DM * DM, 0, F.WSCO + l * DM, v - l * S_O); } } }
    float* scr = (float*)(F.lds + F.wave * 16896);
    constexpr int I_FO = (DFF / 128) * (DM / 32)  ;
    constexpr int I_MI = (DM / 128) * (2 * DFE / 32)  , I_MO = (DFE / 128) * (DM / 32);
    constexpr int NITEMS = I_FO + 8 * I_MI + 8 * I_MO;
    static_assert(NITEMS % 64 == 0, "items are taken eight at a time, interleaved inside groups of 64");
    int cur = 0; if (F.lane == 0) cur = (int)__hip_atomic_fetch_add(F.ctl + CW_Q, 8u, __ATOMIC_RELAXED, __HIP_MEMORY_SCOPE_AGENT); cur = __builtin_amdgcn_readfirstlane(cur);
    while (cur < NITEMS) {
        int nxt = 0; if (F.lane == 0) nxt = (int)__hip_atomic_fetch_add(F.ctl + CW_Q, 8u, __ATOMIC_RELAXED, __HIP_MEMORY_SCOPE_AGENT);
        const int ibase = 64 * (cur >> 6) + ((cur >> 3) & 7);
        for (int i8 = 0; i8 < 8; ++i8) { const int it = ibase + 8 * i8;
            int r = it;
            if (r < I_FO) { transpose_item_f8(F.ffn_w_out, DFF, DM, (unsigned char*)F.WFO, 0, 64.0f, scr, r, F.lane); continue; } r -= I_FO;
            if (r < 8 * I_MI) { const int e = r / I_MI; r -= e * I_MI; transpose_item_f8(F.moe_w_in + (size_t)e * DM * 2 * DFE, DM, 2 * DFE, (unsigned char*)F.WMI + (size_t)e * 2 * DFE * DM, DFE, 64.0f, scr, r, F.lane); continue; } r -= 8 * I_MI;
            { const int e = r / I_MO; r -= e * I_MO; transpose_item_f8(F.moe_w_out + (size_t)e * DFE * DM, DFE, DM, (unsigned char*)F.WMO + (size_t)e * DM * DFE, 0, 128.0f, scr, r, F.lane); }
        }
        cur = __builtin_amdgcn_readfirstlane(nxt);
    }
}

__device__ __forceinline__ void phase_rowq(Frame& F, const bf16* A, unsigned char* Q) {
    const int gw = F.vcu * NWAVES + F.wave, NGW = F.G * NWAVES;
    for (int rb = gw; rb < M / 8; rb += NGW) {
        const int m0 = rb * 8;
#pragma unroll
        for (int i0 = 0; i0 < 8; i0 += 4) {
            v2u raw[4][8];
#pragma unroll
            for (int r = 0; r < 4; ++r)
#pragma unroll
                for (int j = 0; j < 8; ++j) raw[r][j] = *(const v2u*)(A + (size_t)(m0 + i0 + r) * DM + 4 * F.lane + 256 * j);
#pragma unroll
            for (int r = 0; r < 4; ++r) { const int i = i0 + r;
                f32x4 v[8]; float am = 0.f;
#pragma unroll
                for (int j = 0; j < 8; ++j) { v[j] = (f32x4){bflo(raw[r][j].x), bfhi(raw[r][j].x), bflo(raw[r][j].y), bfhi(raw[r][j].y)}; am = fmaxf(am, fmaxf(fmaxf(fabsf(v[j][0]), fabsf(v[j][1])), fmaxf(fabsf(v[j][2]), fabsf(v[j][3])))); }
                am = fmaxf(wave_max(am), 1e-30f); const float inv = 127.0f / am;
                unsigned char* orow = Q + (size_t)(m0 + i) * DM + 4 * F.lane;
#pragma unroll
                for (int j = 0; j < 8; ++j) *(unsigned*)(orow + 256 * j) = pack4_i8_nc(v[j][0] * inv, v[j][1] * inv, v[j][2] * inv, v[j][3] * inv);
                if (F.lane == 0) F.HSCALE[m0 + i] = am * (1.0f / 127.0f); }
        }
    }
}

template <bool XB16> __device__ __forceinline__ f32x4 ld4x(const void* base, size_t idx) {
    if constexpr (XB16) { const v2u w = *(const v2u*)((const bf16*)base + idx); return (f32x4){bflo(w.x), bfhi(w.x), bflo(w.y), bfhi(w.y)}; }
    else return *(const f32x4*)((const float*)base + idx);
}
template <bool XB16> struct RawRow { typedef f32x4 T; }; template <> struct RawRow<true> { typedef v2u T; };
template <bool XB16> __device__ __forceinline__ typename RawRow<XB16>::T ldraw(const void* base, size_t idx) {
    if constexpr (XB16) return *(const v2u*)((const bf16*)base + idx); else return *(const f32x4*)((const float*)base + idx);
}
__device__ __forceinline__ f32x4 unraw(const v2u w) { return (f32x4){bflo(w.x), bfhi(w.x), bflo(w.y), bfhi(w.y)}; }
__device__ __forceinline__ f32x4 unraw(const f32x4 w) { return w; }
template <bool I8OUT, bool XB16> __device__ __forceinline__ void phase_norm(Frame& F, const void* X, const float* gain, int l, int ch_sh, int ch_sc, bf16* HB) {
    const int gw = F.vcu * NWAVES + F.wave, NGW = F.G * NWAVES;
    for (int rb = gw; rb < M / 8; rb += NGW) {
        const int m0 = rb * 8, b = m0 / SEQ;
        const float* modb = F.MOD + (size_t)(l * 8 + b) * NMOD;
        f32x4 a[8], s[8];
#pragma unroll
        for (int j = 0; j < 8; ++j) { const int col = 4 * F.lane + 256 * j; const f32x4 g = *(const f32x4*)(gain + col), sc = *(const f32x4*)(modb + ch_sc * DM + col); a[j] = g * (sc + 1.0f); s[j] = *(const f32x4*)(modb + ch_sh * DM + col); }
#pragma unroll
        for (int i0 = 0; i0 < 8; i0 += 4) {
            typename RawRow<XB16>::T raw[4][8];
#pragma unroll
            for (int r = 0; r < 4; ++r)
#pragma unroll
                for (int j = 0; j < 8; ++j) raw[r][j] = ldraw<XB16>(X, (size_t)(m0 + i0 + r) * DM + 4 * F.lane + 256 * j);
#pragma unroll
            for (int r = 0; r < 4; ++r) { const int i = i0 + r;
                f32x4 v[8]; float ss = 0.f;
#pragma unroll
                for (int j = 0; j < 8; ++j) { v[j] = unraw(raw[r][j]); ss += (v[j][0] * v[j][0] + v[j][1] * v[j][1]) + (v[j][2] * v[j][2] + v[j][3] * v[j][3]); }
                const float rstd = 1.0f / sqrtf(wave_sum(ss) * (1.0f / DM) + EPS);
                if constexpr (I8OUT) {
                    float am = 0.f;
#pragma unroll
                    for (int j = 0; j < 8; ++j) { v[j] = v[j] * rstd * a[j] + s[j]; am = fmaxf(am, fmaxf(fmaxf(fabsf(v[j][0]), fabsf(v[j][1])), fmaxf(fabsf(v[j][2]), fabsf(v[j][3])))); }
                    am = fmaxf(wave_max(am), 1e-30f); const float inv = 127.0f / am;
                    unsigned char* orow = (unsigned char*)HB + (size_t)(m0 + i) * DM + 4 * F.lane;
#pragma unroll
                    for (int j = 0; j < 8; ++j) *(unsigned*)(orow + 256 * j) = pack4_i8_nc(v[j][0] * inv, v[j][1] * inv, v[j][2] * inv, v[j][3] * inv);
                    if (F.lane == 0) F.HSCALE[m0 + i] = am * (1.0f / 127.0f); }
                else { bf16* orow = HB + (size_t)(m0 + i) * DM + 4 * F.lane;
#pragma unroll
                    for (int j = 0; j < 8; ++j) { const f32x4 h = v[j] * rstd * a[j] + s[j]; v2u o; o.x = pk2(h[0], h[1]); o.y = pk2(h[2], h[3]); *(v2u*)(orow + 256 * j) = o; } }
            }
        }
    }
}

typedef short bf16x8 __attribute__((ext_vector_type(8)));
typedef float f32x16 __attribute__((ext_vector_type(16)));
typedef float f32x2_t __attribute__((ext_vector_type(2))); typedef __bf16 bf16x2_t __attribute__((ext_vector_type(2)));
__device__ __forceinline__ unsigned cvtpk(float lo, float hi) { f32x2_t v = {lo, hi}; bf16x2_t b = __builtin_convertvector(v, bf16x2_t); return __builtin_bit_cast(unsigned, b); }
__device__ __forceinline__ void xhalf(float x, float& lo, float& hi) { const unsigned a = __builtin_bit_cast(unsigned, x); auto rr = __builtin_amdgcn_permlane32_swap(a, a, false, false); const unsigned x0 = rr[0], x1 = rr[1]; lo = __builtin_bit_cast(float, x0); hi = __builtin_bit_cast(float, x1); }
#define PK4(P, B_, OUT) do { unsigned a0_ = cvtpk(P[B_+0], P[B_+1]), a1_ = cvtpk(P[B_+2], P[B_+3]); unsigned b0_ = cvtpk(P[B_+4], P[B_+5]), b1_ = cvtpk(P[B_+6], P[B_+7]);  \
        auto r0_ = __builtin_amdgcn_permlane32_swap(a0_, b0_, false, false); auto r1_ = __builtin_amdgcn_permlane32_swap(a1_, b1_, false, false); \
        v4u w_ = {r0_[0], r1_[0], r0_[1], r1_[1]}; OUT = __builtin_bit_cast(bf16x8, w_); } while (0)
__device__ __forceinline__ v4u pair16(unsigned a0, unsigned a1, unsigned b0, unsigned b1) {
    auto r0_ = __builtin_amdgcn_permlane32_swap(a0, b0, false, false); auto r1_ = __builtin_amdgcn_permlane32_swap(a1, b1, false, false);
    v4u w_ = {r0_[0], r1_[0], r0_[1], r1_[1]}; return w_; }
constexpr int QKP = 2 * DM;

__device__ __forceinline__ void phase_sb(Frame& F) {
    const int gw = F.vcu * NWAVES + F.wave, NGW = F.G * NWAVES, lane = F.lane, r32 = lane & 31, hi = lane >> 5;
    constexpr float C = -ATT_SCALE * LOG2E;
    for (int item = gw; item < NB * NH * (SEQ / 32); item += NGW) {
        const int bh = item >> 6, qt = item & 63, b = bh >> 4, h = bh & 15, q0 = qt * 32;
        const bf16* Qp = F.QK + (size_t)(b * SEQ + q0 + r32) * QKP + h * HD + hi * 8;
        bf16x8 qr[8];
#pragma unroll
        for (int d0 = 0; d0 < 8; ++d0) qr[d0] = *(const bf16x8*)(Qp + d0 * 16);
        const bf16* Kb = F.QK + (size_t)(b * SEQ + r32) * QKP + DM + h * HD + hi * 8;
        const bf16* Vb = F.VT + (size_t)(h * HD + r32) * M + b * SEQ + hi * 8;
        f32x16 o[4];
#pragma unroll
        for (int d0 = 0; d0 < 4; ++d0)
#pragma unroll
            for (int r = 0; r < 16; ++r) o[d0][r] = 0.f;
        float carry = 1.0f;
        bf16x8 kf[8], kn[8], vf[8];
#pragma unroll
        for (int d0 = 0; d0 < 8; ++d0) kf[d0] = *(const bf16x8*)(Kb + (size_t)q0 * QKP + d0 * 16);
        for (int j = qt; j >= 0; --j) {
            const int kb = j * 32, jn = j > 0 ? j - 1 : 0;
#pragma unroll
            for (int i = 0; i < 8; ++i) vf[i] = *(const bf16x8*)(Vb + (size_t)((i >> 1) * 32) * M + kb + (i & 1) * 16);
#pragma unroll
            for (int d0 = 0; d0 < 8; ++d0) kn[d0] = *(const bf16x8*)(Kb + (size_t)(jn * 32) * QKP + d0 * 16);
            f32x16 p;
#pragma unroll
            for (int r = 0; r < 16; ++r) p[r] = 0.f;
#pragma unroll
            for (int d0 = 0; d0 < 8; ++d0) p = __builtin_amdgcn_mfma_f32_32x32x16_bf16(kf[d0], qr[d0], p, 0, 0, 0);
            float beta[16], keep[16];
            const bool diag = (j == qt);
#pragma unroll
            for (int r = 0; r < 16; ++r) {
                const float e = __builtin_amdgcn_exp2f(fminf(p[r] * C, 126.0f));
                float bt = __builtin_amdgcn_rcpf(1.0f + e), kp = e * bt;
                if (diag) { const bool valid = ((r & 3) + 8 * (r >> 2) + 4 * hi) < r32; kp = valid ? kp : 1.0f; bt = valid ? bt : 0.f; }
                beta[r] = bt; keep[r] = kp;
            }
            float e2[4], e1[4], e0[4], Ge[4], Go[4];
#pragma unroll
            for (int k = 0; k < 4; ++k) { e2[k] = keep[4 * k + 3]; e1[k] = e2[k] * keep[4 * k + 2]; e0[k] = e1[k] * keep[4 * k + 1]; const float g = e0[k] * keep[4 * k];
                xhalf(g, Ge[k], Go[k]); }
            float Te[4], To[4];
            To[3] = 1.0f; Te[3] = Go[3]; To[2] = Te[3] * Ge[3]; Te[2] = To[2] * Go[2]; To[1] = Te[2] * Ge[2]; Te[1] = To[1] * Go[1]; To[0] = Te[1] * Ge[1]; Te[0] = To[0] * Go[0];
            const float total = Te[0] * Ge[0];
#pragma unroll
            for (int k = 0; k < 4; ++k) { const float ck = carry * (hi ? To[k] : Te[k]);
                p[4 * k + 3] = beta[4 * k + 3] * ck; p[4 * k + 2] = beta[4 * k + 2] * (ck * e2[k]); p[4 * k + 1] = beta[4 * k + 1] * (ck * e1[k]); p[4 * k] = beta[4 * k] * (ck * e0[k]); }
            carry *= total;
            bf16x8 pa0, pa1; PK4(p, 0, pa0); PK4(p, 8, pa1);
#pragma unroll
            for (int d0 = 0; d0 < 4; ++d0) { o[d0] = __builtin_amdgcn_mfma_f32_32x32x16_bf16(vf[2 * d0], pa0, o[d0], 0, 0, 0); o[d0] = __builtin_amdgcn_mfma_f32_32x32x16_bf16(vf[2 * d0 + 1], pa1, o[d0], 0, 0, 0); }
#pragma unroll
            for (int d0 = 0; d0 < 8; ++d0) kf[d0] = kn[d0];
            if (__all(carry < 2.3283064e-10f)) break;
        }
        bf16* Op = F.AO + (size_t)(b * SEQ + q0 + r32) * DM + h * HD + 8 * hi;
#pragma unroll
        for (int d0 = 0; d0 < 4; ++d0)
#pragma unroll
            for (int g = 0; g < 4; g += 2)
                *(v4u*)(Op + d0 * 32 + 8 * g) = pair16(cvtpk(o[d0][4 * g], o[d0][4 * g + 1]), cvtpk(o[d0][4 * g + 2], o[d0][4 * g + 3]), cvtpk(o[d0][4 * g + 4], o[d0][4 * g + 5]), cvtpk(o[d0][4 * g + 6], o[d0][4 * g + 7]));
    }
}

__device__ __forceinline__ void phase_qknorm(Frame& F) {
    float* part = (float*)F.lds;
    const int lane = F.lane, c = lane & 15, rs = lane >> 4;
    const f32x4 g0 = *(const f32x4*)(F.qn_k + 8 * c), g1 = *(const f32x4*)(F.qn_k + 8 * c + 4);
    for (int u = blockIdx.x; u < NB * 8 * NH; u += F.G) {
        const int h = u & 15, blk = (u >> 4) & 7, b = u >> 7;
        bf16* base = F.QK + (size_t)(b * SEQ + blk * 256 + F.wave * 32 + rs) * QKP + DM + h * HD + 8 * c;
        v4u kp[8];
#pragma unroll
        for (int i = 0; i < 8; ++i) kp[i] = *(const v4u*)(base + (size_t)(4 * i) * QKP);
        f32x4 ks0 = (f32x4){0.f, 0.f, 0.f, 0.f}, ks1 = ks0;
#pragma unroll
        for (int i = 0; i < 8; ++i) {
            const f32x4 k0 = (f32x4){bflo(kp[i].x), bfhi(kp[i].x), bflo(kp[i].y), bfhi(kp[i].y)}, k1 = (f32x4){bflo(kp[i].z), bfhi(kp[i].z), bflo(kp[i].w), bfhi(kp[i].w)};
            float sq = ((k0[0] * k0[0] + k0[1] * k0[1]) + (k0[2] * k0[2] + k0[3] * k0[3])) + ((k1[0] * k1[0] + k1[1] * k1[1]) + (k1[2] * k1[2] + k1[3] * k1[3]));
            sq += dppf<0xB1>(sq); sq += dppf<0x4E>(sq); sq += dppf<0x141>(sq); sq += dppf<0x140>(sq);
            const float rk = 1.0f / sqrtf(sq * (1.0f / HD) + EPS);
            const f32x4 n0 = k0 * rk * g0, n1 = k1 * rk * g1;
            ks0 += n0; ks1 += n1;
            v4u o; o.x = pk2(n0[0], n0[1]); o.y = pk2(n0[2], n0[3]); o.z = pk2(n1[0], n1[1]); o.w = pk2(n1[2], n1[3]);
            *(v4u*)(base + (size_t)(4 * i) * QKP) = o;
        }
#pragma unroll
        for (int e = 0; e < 4; ++e) { ks0[e] += __shfl_xor(ks0[e], 16); ks0[e] += __shfl_xor(ks0[e], 32); ks1[e] += __shfl_xor(ks1[e], 16); ks1[e] += __shfl_xor(ks1[e], 32); }
        if (rs == 0) { *(f32x4*)(part + F.wave * 128 + 8 * c) = ks0; *(f32x4*)(part + F.wave * 128 + 8 * c + 4) = ks1; }
        __syncthreads();
        if (F.tid < 128) { float sm = 0.f;
#pragma unroll
            for (int w = 0; w < 8; ++w) sm += part[w * 128 + F.tid];
            F.KMEAN[((size_t)(b * NH + h) * 8 + blk) * HD + F.tid] = sm * (1.0f / 256.0f); }
        __syncthreads();
    }
}

#define SBAR() __builtin_amdgcn_sched_barrier(0)
__device__ __forceinline__ void phase_moba(Frame& F) {
    const int lane = F.lane, r32 = lane & 31, hi = lane >> 5, w = F.wave;
    PG8_LAS unsigned char* ldsl = (PG8_LAS unsigned char*)F.lds;
    const float bound2 = 2.0f * (ATT_SCALE * LOG2E) * (float)HD * wave_max(fmaxf(fabsf(F.qn_q[2 * lane]), fabsf(F.qn_q[2 * lane + 1]))) * wave_max(fmaxf(fabsf(F.qn_k[2 * lane]), fabsf(F.qn_k[2 * lane + 1])));
    for (int P = F.vcu; P < NB * NH * 4; P += F.G) {
      const int bh = P >> 2, b = bh >> 4, h = (P >= NB * NH * 2) ? 15 - (bh & 15) : (bh & 15);
      for (int half = 0; half < 2; ++half) {
        const int qb = half ? 7 - (P & 3) : (P & 3), q0 = qb * 256 + 32 * w, t = q0 + r32, NT = 8 * (qb + 1);
        const float slope2 = exp2f(-0.5f * (float)(h + 1)) * LOG2E;
        const int Dk = (int)fminf((58.0f + bound2) / slope2 + 1.0f, 4096.0f);
        const int jbeg = (qb * 256 - Dk) > 0 ? (qb * 256 - Dk) >> 5 : 0;
        const int jfirst = (q0 - Dk) > 0 ? (q0 - Dk) >> 5 : 0;
        const bf16* Qp = F.QK + (size_t)(b * SEQ + t) * QKP + h * HD + hi * 8;
        const int ktid = w * 64 + lane; const bool kst_on = ktid < 32 * qb; f32x4 kst = {0.f, 0.f, 0.f, 0.f};
        if (kst_on) kst = *(const f32x4*)(F.KMEAN + ((size_t)(b * NH + h) * 8) * HD + 4 * ktid);
        bf16x8 qr[8];
#pragma unroll
        for (int d0 = 0; d0 < 8; ++d0) qr[d0] = *(const bf16x8*)(Qp + d0 * 16);
        { float ss = 0.f;
#pragma unroll
          for (int d0 = 0; d0 < 8; ++d0) { const v4u qq = __builtin_bit_cast(v4u, qr[d0]); ss += bflo(qq.x) * bflo(qq.x) + bfhi(qq.x) * bfhi(qq.x) + bflo(qq.y) * bflo(qq.y) + bfhi(qq.y) * bfhi(qq.y) + bflo(qq.z) * bflo(qq.z) + bfhi(qq.z) * bfhi(qq.z) + bflo(qq.w) * bflo(qq.w) + bfhi(qq.w) * bfhi(qq.w); }
          float slo, shi; xhalf(ss, slo, shi); const float rq = (ATT_SCALE * LOG2E) / sqrtf((slo + shi) * (1.0f / HD) + EPS);
#pragma unroll
          for (int d0 = 0; d0 < 8; ++d0) { const f32x4 g0 = *(const f32x4*)(F.qn_q + d0 * 16 + hi * 8) * rq, g1 = *(const f32x4*)(F.qn_q + d0 * 16 + hi * 8 + 4) * rq; const v4u qq = __builtin_bit_cast(v4u, qr[d0]);
              v4u o; o.x = cvtpk(bflo(qq.x) * g0[0], bfhi(qq.x) * g0[1]); o.y = cvtpk(bflo(qq.y) * g0[2], bfhi(qq.y) * g0[3]); o.z = cvtpk(bflo(qq.z) * g1[0], bfhi(qq.z) * g1[1]); o.w = cvtpk(bflo(qq.w) * g1[2], bfhi(qq.w) * g1[3]);
              qr[d0] = __builtin_bit_cast(bf16x8, o); } }
        const bf16* src0; const bf16* src1; size_t tstep;
        if (w < 4) { src0 = F.QK + (size_t)(b * SEQ + r32) * QKP + DM + h * HD + hi * 8 + (2 * w) * 16; src1 = src0 + 16; tstep = (size_t)32 * QKP; }
        else { src0 = F.VT + (size_t)(h * HD + (w - 4) * 32 + r32) * M + b * SEQ + hi * 8; src1 = src0 + 16; tstep = 32; }
        const unsigned dst0 = (unsigned)(w < 4 ? (2 * w) * 1024 : (8 + 2 * (w - 4)) * 1024);
#define MOBA_ISSUE(j_, boff_) do { __builtin_amdgcn_global_load_lds((const unsigned*)(src0 + (size_t)(j_) * tstep), (PG8_LAS unsigned*)(ldsl + (boff_) + dst0), 16, 0, 0); \
                                   __builtin_amdgcn_global_load_lds((const unsigned*)(src1 + (size_t)(j_) * tstep), (PG8_LAS unsigned*)(ldsl + (boff_) + dst0 + 1024), 16, 0, 0); } while (0)
        int bv = 65536, bk = 81920, bn = 0, bn2 = 16384, bn3 = 32768, bn4 = 49152;
        MOBA_ISSUE(jbeg, 0); MOBA_ISSUE(jbeg + 1, 16384); MOBA_ISSUE(jbeg + 2, 32768); MOBA_ISSUE(jbeg + 3, 49152);
        unsigned sel = 0u;
        PG8_LAS float* kms = (PG8_LAS float*)(ldsl + 6 * 16384);
        if (kst_on) *(PG8_LAS f32x4*)(kms + 4 * ktid) = kst;
        asm volatile("s_waitcnt lgkmcnt(0)" ::: "memory"); __builtin_amdgcn_s_barrier(); asm volatile("" ::: "memory");
        { float gate[7];
#pragma unroll
          for (int n = 0; n < 7; ++n) { gate[n] = 0.f; if (n < qb) { PG8_LAS const float* km = kms + n * HD + hi * 8; float sg = 0.f;
#pragma unroll
                for (int d0 = 0; d0 < 8; ++d0) { const f32x4 k0 = *(PG8_LAS const f32x4*)(km + d0 * 16), k1 = *(PG8_LAS const f32x4*)(km + d0 * 16 + 4); const v4u qq = __builtin_bit_cast(v4u, qr[d0]);
                    sg += bflo(qq.x) * k0[0] + bfhi(qq.x) * k0[1] + bflo(qq.y) * k0[2] + bfhi(qq.y) * k0[3] + bflo(qq.z) * k1[0] + bfhi(qq.z) * k1[1] + bflo(qq.w) * k1[2] + bfhi(qq.w) * k1[3]; }
                float glo, ghi; xhalf(sg, glo, ghi); gate[n] = glo + ghi; } }
#pragma unroll
          for (int n = 0; n < 7; ++n) if (n < qb) { int rank = 0;
#pragma unroll
              for (int m2 = 0; m2 < 7; ++m2) if (m2 != n && m2 < qb) rank += (gate[m2] > gate[n] || (gate[m2] == gate[n] && m2 < n)) ? 1 : 0;
              if (rank < 3) sel |= 1u << n; } }
        f32x16 o[4];
#pragma unroll
        for (int d0 = 0; d0 < 4; ++d0)
#pragma unroll
            for (int r = 0; r < 16; ++r) o[d0][r] = 0.f;
        float m_reg = -1e30f, l_reg = 0.f;
        const int jlast = 8 * qb + w;
        const float NEG = -__builtin_inff();
        f32x16 pA, pB; bf16x8 kf[8], vf[8], pa0, pa1;
#define MOBA_TOP(j_) do { { const int rem_ = NT - 1 - (j_);     \
              if (rem_ >= 3) asm volatile("s_waitcnt vmcnt(6) lgkmcnt(0)" ::: "memory"); else if (rem_ == 2) asm volatile("s_waitcnt vmcnt(4) lgkmcnt(0)" ::: "memory"); \
              else if (rem_ == 1) asm volatile("s_waitcnt vmcnt(2) lgkmcnt(0)" ::: "memory"); else asm volatile("s_waitcnt vmcnt(0) lgkmcnt(0)" ::: "memory"); } \
            __builtin_amdgcn_s_barrier(); asm volatile("" ::: "memory"); { const int t_ = bv; bv = bk; bk = bn; bn = bn2; bn2 = bn3; bn3 = bn4; bn4 = t_; } if ((j_) + 4 < NT) MOBA_ISSUE((j_) + 4, bn4); } while (0)
#define MOBA_LDK() do { PG8_LAS const unsigned char* kb_ = ldsl + bk + lane * 16; _Pragma("unroll") for (int i = 0; i < 8; ++i) kf[i] = *(PG8_LAS const bf16x8*)(kb_ + i * 1024); } while (0)
#define MOBA_LDKH(h_) do { PG8_LAS const unsigned char* kb_ = ldsl + bk + lane * 16 + (h_) * 4096; _Pragma("unroll") for (int i = 0; i < 4; ++i) kf[(h_) * 4 + i] = *(PG8_LAS const bf16x8*)(kb_ + i * 1024); } while (0)
#define MOBA_LDVH(boff_, h_) do { PG8_LAS const unsigned char* vb_ = ldsl + (boff_) + 8192 + lane * 16 + (h_) * 4096; _Pragma("unroll") for (int i = 0; i < 4; ++i) vf[(h_) * 4 + i] = *(PG8_LAS const bf16x8*)(vb_ + i * 1024); } while (0)
#define MOBA_LDV(boff_) do { PG8_LAS const unsigned char* vb_ = ldsl + (boff_) + 8192 + lane * 16; _Pragma("unroll") for (int i = 0; i < 8; ++i) vf[i] = *(PG8_LAS const bf16x8*)(vb_ + i * 1024); } while (0)
#define MOBA_INIT(PN, j_) do { const float ab_ = slope2 * (float)((j_) * 32 + 4 * hi - t); _Pragma("unroll") for (int r = 0; r < 16; ++r) PN[r] = fmaf(slope2, (float)((r & 3) + 8 * (r >> 2)), ab_); } while (0)
#define MOBA_QK(PN, d_) PN = __builtin_amdgcn_mfma_f32_32x32x16_bf16(kf[d_], qr[d_], PN, 0, 0, 0)
#define SM_MAXA(PC) float mx_ = fmaxf(fmaxf(fmaxf(PC[0], PC[1]), fmaxf(PC[2], PC[3])), fmaxf(fmaxf(PC[4], PC[5]), fmaxf(PC[6], PC[7])))
#define SM_MAXB(PC) mx_ = fmaxf(mx_, fmaxf(fmaxf(fmaxf(PC[8], PC[9]), fmaxf(PC[10], PC[11])), fmaxf(fmaxf(PC[12], PC[13]), fmaxf(PC[14], PC[15]))))
#define SM_DECIDE() do { float mlo_, mhi_; xhalf(mx_, mlo_, mhi_); mx_ = fmaxf(mlo_, mhi_); \
            if (!__all(mx_ - m_reg <= 8.0f)) { const float mn_ = fmaxf(m_reg, mx_), alpha_ = __builtin_amdgcn_exp2f(m_reg - mn_); m_reg = mn_; l_reg *= alpha_; \
                _Pragma("unroll") for (int d0 = 0; d0 < 4; ++d0) _Pragma("unroll") for (int r = 0; r < 16; ++r) o[d0][r] *= alpha_; } } while (0)
#define SM_EXP4(PC, B_) do { PC[B_] = __builtin_amdgcn_exp2f(PC[B_] - m_reg); PC[B_ + 1] = __builtin_amdgcn_exp2f(PC[B_ + 1] - m_reg); PC[B_ + 2] = __builtin_amdgcn_exp2f(PC[B_ + 2] - m_reg); PC[B_ + 3] = __builtin_amdgcn_exp2f(PC[B_ + 3] - m_reg); \
            ps_ += (PC[B_] + PC[B_ + 1]) + (PC[B_ + 2] + PC[B_ + 3]); } while (0)
#define MOBA_PV() do { _Pragma("unroll") for (int d0 = 0; d0 < 4; ++d0) { o[d0] = __builtin_amdgcn_mfma_f32_32x32x16_bf16(vf[2 * d0], pa0, o[d0], 0, 0, 0); o[d0] = __builtin_amdgcn_mfma_f32_32x32x16_bf16(vf[2 * d0 + 1], pa1, o[d0], 0, 0, 0); } } while (0)
#define MOBA_STEP(PN, PC, j_) do { MOBA_LDKH(0); MOBA_INIT(PN, j_); \
            { const int n1_ = ((j_) - 1) >> 3; if (n1_ < qb) { if (!((sel >> n1_) & 1u)) { _Pragma("unroll") for (int r = 0; r < 16; ++r) PC[r] = NEG; } } } \
            SBAR(); MOBA_QK(PN, 0); SM_MAXA(PC); SBAR(); MOBA_QK(PN, 1); MOBA_LDKH(1); SM_MAXB(PC); SBAR(); MOBA_QK(PN, 2); SM_DECIDE(); float ps_ = 0.f; SBAR(); \
            MOBA_QK(PN, 3); SM_EXP4(PC, 0); SBAR(); MOBA_QK(PN, 4); SM_EXP4(PC, 4); SBAR(); MOBA_QK(PN, 5); MOBA_LDVH(bv, 0); SM_EXP4(PC, 8); SBAR(); MOBA_QK(PN, 6); SM_EXP4(PC, 12); SBAR(); \
            MOBA_QK(PN, 7); MOBA_LDVH(bv, 1); l_reg += ps_; PK4(PC, 0, pa0); PK4(PC, 8, pa1); SBAR(); MOBA_PV(); } while (0)
#define MOBA_DRAIN(PC) do { MOBA_LDV(bk); \
            _Pragma("unroll") for (int r = 0; r < 16; ++r) if (((r & 3) + 8 * (r >> 2) + 4 * hi) > r32) PC[r] = NEG; \
            SM_MAXA(PC); SM_MAXB(PC); SM_DECIDE(); float ps_ = 0.f; SM_EXP4(PC, 0); SM_EXP4(PC, 4); SM_EXP4(PC, 8); SM_EXP4(PC, 12); l_reg += ps_; PK4(PC, 0, pa0); PK4(PC, 8, pa1); MOBA_PV(); } while (0)
        for (int jj = jbeg; jj < jfirst; ++jj) MOBA_TOP(jj);
        MOBA_TOP(jfirst); MOBA_LDK(); MOBA_INIT(pA, jfirst);
#pragma unroll
        for (int d0 = 0; d0 < 8; ++d0) MOBA_QK(pA, d0);
        for (int j = jfirst + 1; j <= jlast; ++j) { pB = pA; MOBA_TOP(j); MOBA_STEP(pA, pB, j); }
        pB = pA; MOBA_DRAIN(pB);
        for (int jj = jlast + 1; jj < NT; ++jj) MOBA_TOP(jj);
        { float llo, lhi; xhalf(l_reg, llo, lhi); l_reg = llo + lhi; }
        const float il = 1.0f / l_reg;
        bf16* Op = F.AO + (size_t)(b * SEQ + t) * DM + h * HD + 8 * hi;
#pragma unroll
        for (int d0 = 0; d0 < 4; ++d0)
#pragma unroll
            for (int g = 0; g < 4; g += 2)
                *(v4u*)(Op + d0 * 32 + 8 * g) = pair16(cvtpk(o[d0][4 * g] * il, o[d0][4 * g + 1] * il), cvtpk(o[d0][4 * g + 2] * il, o[d0][4 * g + 3] * il), cvtpk(o[d0][4 * g + 4] * il, o[d0][4 * g + 5] * il), cvtpk(o[d0][4 * g + 6] * il, o[d0][4 * g + 7] * il));
        __syncthreads();
      }
    }
#undef MOBA_ISSUE
#undef MOBA_TOP
#undef MOBA_LDK
#undef MOBA_LDV
#undef MOBA_INIT
#undef MOBA_QK
#undef SM_MAXA
#undef SM_MAXB
#undef SM_DECIDE
#undef SM_EXP4
#undef MOBA_PV
#undef MOBA_STEP
#undef MOBA_DRAIN
}
#undef SBAR

__device__ __forceinline__ void phase_router(Frame& F, const bf16* X) {
    float* wr = (float*)F.lds;
    int* selE = (int*)(F.lds + 65536); float* selW = (float*)(F.lds + 65536 + 1024); int* selR = (int*)(F.lds + 65536 + 2048);
    for (int i = F.tid; i < DM * NE; i += NWAVES * 64) { const int col = i >> 3, e = i & 7, j = col >> 8, ln = (col & 255) >> 2, c = col & 3; wr[((j * 4 + c) * 64 + ln) * 8 + e] = F.router_w[i]; }
    __syncthreads();
    const int lane = F.lane;
    for (int grp = blockIdx.x; grp < M / 64; grp += F.G) {
        const int m0 = grp * 64 + F.wave * 8, b = (grp * 64) / SEQ;
        const float* modb = F.MOD + (size_t)(8 + b) * NMOD;
        f32x4 a[8], s[8];
#pragma unroll
        for (int j = 0; j < 8; ++j) { const int col = 4 * lane + 256 * j; const f32x4 g = *(const f32x4*)(F.ffn_norm + DM + col), sc = *(const f32x4*)(modb + 4 * DM + col); a[j] = g * (sc + 1.0f); s[j] = *(const f32x4*)(modb + 3 * DM + col); }
#pragma unroll 1
        for (int i0 = 0; i0 < 8; i0 += 4) {
          v2u raw[4][8];
#pragma unroll
          for (int r = 0; r < 4; ++r)
#pragma unroll
            for (int j = 0; j < 8; ++j) raw[r][j] = *(const v2u*)(X + (size_t)(m0 + i0 + r) * DM + 4 * lane + 256 * j);
#pragma unroll
          for (int r = 0; r < 4; ++r) { const int i = i0 + r;
            f32x4 v[8]; float ss = 0.f;
#pragma unroll
            for (int j = 0; j < 8; ++j) { v[j] = unraw(raw[r][j]); ss += (v[j][0] * v[j][0] + v[j][1] * v[j][1]) + (v[j][2] * v[j][2] + v[j][3] * v[j][3]); }
            const float rstd = 1.0f / sqrtf(wave_sum(ss) * (1.0f / DM) + EPS);
            float pe[8];
#pragma unroll
            for (int e = 0; e < 8; ++e) pe[e] = 0.f;
#pragma unroll
            for (int j = 0; j < 8; ++j) { const f32x4 hh = v[j] * rstd * a[j] + s[j];
#pragma unroll
                for (int c = 0; c < 4; ++c) { const float* wp = wr + ((j * 4 + c) * 64 + lane) * 8; const f32x4 w0 = *(const f32x4*)wp, w1 = *(const f32x4*)(wp + 4);
                    pe[0] += hh[c] * w0[0]; pe[1] += hh[c] * w0[1]; pe[2] += hh[c] * w0[2]; pe[3] += hh[c] * w0[3]; pe[4] += hh[c] * w1[0]; pe[5] += hh[c] * w1[1]; pe[6] += hh[c] * w1[2]; pe[7] += hh[c] * w1[3]; } }
#pragma unroll
            for (int e = 0; e < 8; ++e) pe[e] = wave_sum(pe[e]);
            int e0 = 0; float l0 = pe[0];
#pragma unroll
            for (int e = 1; e < 8; ++e) if (pe[e] > l0) { l0 = pe[e]; e0 = e; }
            int e1 = -1; float l1 = -__builtin_inff();
#pragma unroll
            for (int e = 0; e < 8; ++e) if (e != e0 && pe[e] > l1) { l1 = pe[e]; e1 = e; }
            const float w0 = 1.0f / (1.0f + __expf(l1 - l0));
            if (lane == 0) { const int tk = F.wave * 8 + i; selE[tk] = e0 | (e1 << 8); selW[2 * tk] = w0; selW[2 * tk + 1] = 1.0f - w0; }
          }
        }
        __syncthreads();
        if (F.wave == 0) {
            const int ee = selE[lane], me0 = ee & 255, me1 = ee >> 8; int r0 = 0, r1 = 0;
            const unsigned long long lt = (1ull << lane) - 1ull;
            int mycnt = 0;
#pragma unroll
            for (int e = 0; e < 8; ++e) { const int c = __popcll(__ballot(me0 == e)) + __popcll(__ballot(me1 == e)); mycnt = (lane == e) ? c : mycnt; }
            unsigned basev = 0;
            if (lane < 8) basev = __hip_atomic_fetch_add(F.ctl + CW_CNT + 64 * lane, (unsigned)mycnt, __ATOMIC_RELAXED, __HIP_MEMORY_SCOPE_AGENT);
#pragma unroll
            for (int e = 0; e < 8; ++e) {
                const unsigned long long m0b = __ballot(me0 == e), m1b = __ballot(me1 == e);
                const int c0 = __popcll(m0b); const int basee = __builtin_amdgcn_readlane((int)basev, e);
                if (me0 == e) r0 = basee + __popcll(m0b & lt);
                if (me1 == e) r1 = basee + c0 + __popcll(m1b & lt);
            }
            selR[2 * lane] = me0 * ECAP + r0; selR[2 * lane + 1] = me1 * ECAP + r1;
            const int tok = grp * 64 + lane;
            F.POSC[2 * tok] = me0 * ECAP + r0; F.POSC[2 * tok + 1] = me1 * ECAP + r1;
            F.GWC[me0 * ECAP + r0] = selW[2 * lane]; F.GWC[me1 * ECAP + r1] = selW[2 * lane + 1];
        }
        __syncthreads();
#pragma unroll 1
        for (int i0 = 0; i0 < 8; i0 += 4) {
          v2u raw[4][8];
#pragma unroll
          for (int r = 0; r < 4; ++r)
#pragma unroll
            for (int j = 0; j < 8; ++j) raw[r][j] = *(const v2u*)(X + (size_t)(m0 + i0 + r) * DM + 4 * lane + 256 * j);
#pragma unroll
          for (int r = 0; r < 4; ++r) { const int i = i0 + r;
            const int tk = F.wave * 8 + i; const int p0 = selR[2 * tk], p1 = selR[2 * tk + 1];
            f32x4 v[8]; float ss = 0.f;
#pragma unroll
            for (int j = 0; j < 8; ++j) { v[j] = unraw(raw[r][j]); ss += (v[j][0] * v[j][0] + v[j][1] * v[j][1]) + (v[j][2] * v[j][2] + v[j][3] * v[j][3]); }
            const float rstd = 1.0f / sqrtf(wave_sum(ss) * (1.0f / DM) + EPS);
            unsigned char* o0 = (unsigned char*)F.HSORT + (size_t)p0 * DM + 4 * lane; unsigned char* o1 = (unsigned char*)F.HSORT + (size_t)p1 * DM + 4 * lane;
#pragma unroll
            for (int j = 0; j < 8; ++j) { const f32x4 hh = v[j] * rstd * a[j] + s[j]; const unsigned o = pg8::cvt4_fp8(hh[0], hh[1], hh[2], hh[3]); *(unsigned*)(o0 + 256 * j) = o; *(unsigned*)(o1 + 256 * j) = o; }
          }
        }
        __syncthreads();
    }
}

__device__ __forceinline__ void moe_setup(Frame& F, pg8::MoeOrder& S, int nN, int a_cap, int b_per_e) {
    int t[8];
#pragma unroll
    for (int e = 0; e < 8; ++e) { const unsigned c = __hip_atomic_load(F.ctl + CW_CNT + 64 * e, __ATOMIC_RELAXED, __HIP_MEMORY_SCOPE_AGENT); t[e] = (int)((c + 255u) >> 8); t[e] = __builtin_amdgcn_readfirstlane(t[e]); }
    S.p1 = t[0]; S.p2 = S.p1 + t[1]; S.p3 = S.p2 + t[2]; S.p4 = S.p3 + t[3]; S.p5 = S.p4 + t[4]; S.p6 = S.p5 + t[5]; S.p7 = S.p6 + t[6]; S.R = S.p7 + t[7];
    if (S.R > MOE_TILES) S.R = MOE_TILES;
    S.nN = nN; S.nwg = S.R * nN; S.G = F.G; S.c = (int)blockIdx.x; S.a_cap = a_cap; S.b_per_e = b_per_e; S.wgm = MK_WGM_MOE; S.xil = (MK_MOE_XIL && F.G == 256 && (32 % MK_WGM_MOE) == 0) ? 1 : 0;
}

__device__ __forceinline__ void phase_combine(Frame& F, const bf16* X, float* out) {
    const int gw = F.vcu * NWAVES + F.wave, NGW = F.G * NWAVES, lane = F.lane;
    int pre[8]; { int acc = 0;
#pragma unroll
        for (int e = 0; e < 8; ++e) { pre[e] = acc; const unsigned c = __hip_atomic_load(F.ctl + CW_CNT + 64 * e, __ATOMIC_RELAXED, __HIP_MEMORY_SCOPE_AGENT); acc += __builtin_amdgcn_readfirstlane((int)((c + 255u) >> 8)); } }
    for (int rb = gw; rb < M / 8; rb += NGW) {
        const int m0 = rb * 8, b = m0 / SEQ;
        const int pcv = F.POSC[2 * m0 + (lane & 15)];
        const float* gf = F.MOD + (size_t)(8 + b) * NMOD + 5 * DM + 4 * lane;
        f32x4 g[8];
#pragma unroll
        for (int j = 0; j < 8; ++j) g[j] = *(const f32x4*)(gf + 256 * j);
        int q[16];
#pragma unroll
        for (int k = 0; k < 16; ++k) { const int pc = __builtin_amdgcn_readlane(pcv, k); const int e = pc >> 14; int bs = 0;
#pragma unroll
            for (int ee = 0; ee < 8; ++ee) bs = (e == ee) ? pre[ee] : bs;
            q[k] = bs * 256 + (pc & 16383); }
        v2u xa[4], ya[4], za[4], xb[4], yb[4], zb[4];
#define CMB_LOAD(st, x_, y_, z_) do { const int i_ = (st) >> 1, c0_ = 1024 * ((st) & 1); const bf16* xp = X + (size_t)(m0 + i_) * DM + 4 * lane + c0_; const int qa_ = q[2 * i_], qb_ = q[2 * i_ + 1]; \
            const bf16* pa_ = F.YP + (size_t)(qa_ < 128 * 256 ? qa_ : 0) * DM + 4 * lane + c0_; const bf16* pb_ = F.YP + (size_t)(qb_ < 128 * 256 ? qb_ : 0) * DM + 4 * lane + c0_; \
            _Pragma("unroll") for (int j = 0; j < 4; ++j) { x_[j] = *(const v2u*)(xp + 256 * j); y_[j] = *(const v2u*)(pa_ + 256 * j); z_[j] = *(const v2u*)(pb_ + 256 * j); } } while (0)
#define CMB_TAIL(qq, c0) do { const float* yt = F.YT + (size_t)((qq) - 128 * 256) * DM + 4 * lane + (c0);              \
            _Pragma("unroll") for (int kc = 0; kc < 4; ++kc) _Pragma("unroll") for (int j = 0; j < 4; ++j) y[j] += *(const f32x4*)(yt + (size_t)kc * (8 * 256) * DM + 256 * j); } while (0)
#define CMB_PROC(st, x_, y_, z_) do { const int i_ = (st) >> 1, c0_ = 1024 * ((st) & 1); const int qa_ = q[2 * i_], qb_ = q[2 * i_ + 1]; float* orow = out + (size_t)(m0 + i_) * DM + 4 * lane + c0_; f32x4 y[4]; \
            _Pragma("unroll") for (int j = 0; j < 4; ++j) y[j] = (f32x4){0.f, 0.f, 0.f, 0.f}; \
            if (qa_ < 128 * 256) { _Pragma("unroll") for (int j = 0; j < 4; ++j) y[j] += unraw(y_[j]); } else CMB_TAIL(qa_, c0_); \
            if (qb_ < 128 * 256) { _Pragma("unroll") for (int j = 0; j < 4; ++j) y[j] += unraw(z_[j]); } else CMB_TAIL(qb_, c0_); \
            _Pragma("unroll") for (int j = 0; j < 4; ++j) *(f32x4*)(orow + 256 * j) = unraw(x_[j]) + g[4 * ((st) & 1) + j] * y[j]; } while (0)
        CMB_LOAD(0, xa, ya, za);
#pragma unroll
        for (int st = 0; st < 16; st += 2) {
            CMB_LOAD(st + 1, xb, yb, zb);
            CMB_PROC(st, xa, ya, za);
            if (st + 2 < 16) CMB_LOAD(st + 2, xa, ya, za);
            CMB_PROC(st + 1, xb, yb, zb);
        }
#undef CMB_LOAD
#undef CMB_TAIL
#undef CMB_PROC
    }
}

__device__ __forceinline__ int lane_id() { int l; asm volatile("v_mbcnt_lo_u32_b32 %0, -1, 0\n\tv_mbcnt_hi_u32_b32 %0, -1, %0" : "=v"(l)); return l; }
__device__ __forceinline__ void fresh_ids(Frame& F) { const int l = lane_id(); F.lane = l; F.wave = F.wave0; F.tid = F.wave0 * 64 + l; }
#ifndef MK_DUP_MASK
#define MK_DUP_MASK 0
#endif
constexpr int NPHASE = 17;
struct Args { const float* in[15]; float* out; unsigned char* ws; int ph_lo, ph_hi; };
__global__ void __launch_bounds__(NWAVES * 64, 2) fwd(Args args) {
    extern __shared__ __attribute__((aligned(16))) unsigned char lds[];
    Frame F;
    F.lds = lds;
    F.wave0 = __builtin_amdgcn_readfirstlane((int)(threadIdx.x >> 6)); fresh_ids(F);
    F.G = gridDim.x; { const int bx = blockIdx.x; F.vcu = (F.G % 8 == 0) ? (bx % 8) * (F.G / 8) + bx / 8 : bx; }
    unsigned char* ws = args.ws;
    F.ctl = (unsigned*)(ws + WS_CTL);
    F.x = args.in[0]; F.c = args.in[1]; F.w_ada = args.in[2]; F.b_ada = args.in[3]; F.attn_norm = args.in[4]; F.ffn_norm = args.in[5]; F.w_qkv = args.in[6]; F.w_o = args.in[7];
    F.qn_q = args.in[8]; F.qn_k = args.in[9]; F.ffn_w_in = args.in[10]; F.ffn_w_out = args.in[11]; F.router_w = args.in[12]; F.moe_w_in = args.in[13]; F.moe_w_out = args.in[14];
    F.out = args.out;
    F.MOD = (float*)(ws + WS_MOD); F.KMEAN = (float*)(ws + WS_KMEAN); F.GWC = (float*)(ws + WS_GWC); F.HSCALE = (float*)(ws + WS_HSCALE); F.WSCFI = (float*)(ws + WS_WSCFI); F.WSCQKV = (float*)(ws + WS_WSCQKV); F.WSCQKV0 = (float*)(ws + WS_WSCQKV + 32768); F.WSCO = (float*)(ws + WS_WSCQKV + 65536); F.POSC = (int*)(ws + WS_POSC);
    F.WQKV = (bf16*)(ws + WS_WQKV); F.WO = (bf16*)(ws + WS_WO); F.WFI = (bf16*)(ws + WS_WFI); F.WFO = (bf16*)(ws + WS_WFO); F.WMI = (bf16*)(ws + WS_WMI); F.WMO = (bf16*)(ws + WS_WMO);
    F.HB = (bf16*)(ws + WS_HB); F.QK = (bf16*)(ws + WS_QKV); F.VT = (bf16*)(ws + WS_QKV + (size_t)M * QKP * 2); F.AO = (bf16*)(ws + WS_AO); F.HID = (bf16*)(ws + WS_HID); F.HSORT = (bf16*)(ws + WS_HSORT); F.HID2 = (bf16*)(ws + WS_HID2); F.YP = (bf16*)(ws + WS_YP); F.YT = (float*)(ws + WS_YT); F.XB = (bf16*)(ws + WS_XB);
    PG8_LAS unsigned char* ldsl = (PG8_LAS unsigned char*)lds;
    for (int u = F.tid; u < (LDS_BYTES - LDSCTL_OFF) / 4; u += NWAVES * 64) ((PG8_LAS unsigned*)(ldsl + LDSCTL_OFF))[u] = 0u;
    __syncthreads();
#if MK_ONE_LAUNCH
    XcdBarrier bar = xcd_barrier_post((unsigned*)(F.ctl + CW_BAR), (volatile LAS unsigned*)(ldsl + MISC_OFF + 32), F.wave0);
#define GRID_BAR() xcd_barrier(bar)
#else
#define GRID_BAR() do { } while (0)
#endif
    const int lo = args.ph_lo, hi = args.ph_hi;
#define IN(k) (lo <= (k) && (k) < hi && (fresh_ids(F), true))
#define SEAM(k) do { if (IN((k) + 1)) GRID_BAR(); } while (0)

    if (IN(0)) { for (int rep_ = 0; rep_ < 1 + ((MK_DUP_MASK >> 0) & 1); ++rep_) { if (rep_) GRID_BAR(); phase_ada(F); } SEAM(0); }
    if (IN(1)) { for (int rep_ = 0; rep_ < 1 + ((MK_DUP_MASK >> 1) & 1); ++rep_) { if (rep_) GRID_BAR(); phase_convert(F); phase_norm<(MK_QKV0_I8 != 0), false>(F, F.x, F.attn_norm, 0, 0, 1, F.HB); } SEAM(1); }
#if !MK_QKV0_I8
    if (IN(2)) { for (int rep_ = 0; rep_ < 1 + ((MK_DUP_MASK >> 2) & 1); ++rep_) { if (rep_) GRID_BAR(); { pg8::Gemm g{F.HB, F.WQKV, M, QKP, DM}; pg8::StaticOrder S; S.init(M, QKP, F.G, (int)blockIdx.x, MK_WGM_QK); pg8::EpiBf16 E{F.QK, QKP};
          pg8::gemm_phase<pg8::EpiBf16, pg8::StaticOrder, true, true>(ldsl + RING_OFF, g, S, E, F.wave0); }
        { pg8::Gemm g{F.WQKV + (size_t)QKP * DM, F.HB, DM, M, DM}; pg8::StaticOrder S; S.init(DM, M, F.G, (int)blockIdx.x, MK_WGM_VT); pg8::EpiBf16 E{F.VT, M};
          pg8::gemm_phase<pg8::EpiBf16, pg8::StaticOrder, true, true>(ldsl + RING_OFF, g, S, E, F.wave0); } } SEAM(2); }
#else
    if (IN(2)) { for (int rep_ = 0; rep_ < 1 + ((MK_DUP_MASK >> 2) & 1); ++rep_) { if (rep_) GRID_BAR();
        { pg8::Gemm g{F.HB, F.WQKV, M, QKP, DM}; pg8::StaticOrder S; S.init(M, QKP, F.G, (int)blockIdx.x, MK_WGM_QK); pg8::EpiBf16i8 E{F.QK, QKP, F.HSCALE, F.WSCQKV0};
          pg8::gemm_phase<pg8::EpiBf16i8, pg8::StaticOrder, true, true, 2>(ldsl + RING_OFF, g, S, E, F.wave0); }
        { pg8::Gemm g{(const bf16*)((const unsigned char*)F.WQKV + (size_t)QKP * DM), F.HB, DM, M, DM}; pg8::StaticOrder S; S.init(DM, M, F.G, (int)blockIdx.x, MK_WGM_VT); pg8::EpiBf16i8 E{F.VT, M, F.WSCQKV0 + QKP, F.HSCALE};
          pg8::gemm_phase<pg8::EpiBf16i8, pg8::StaticOrder, true, true, 2>(ldsl + RING_OFF, g, S, E, F.wave0); } } SEAM(2); }
#endif
    if (IN(3)) { for (int rep_ = 0; rep_ < 1 + ((MK_DUP_MASK >> 3) & 1); ++rep_) { if (rep_) GRID_BAR(); phase_sb(F); } GRID_BAR(); fresh_ids(F); phase_rowq(F, F.AO, (unsigned char*)F.HB); SEAM(3); }
    if (IN(4)) { pg8::Gemm g{F.HB, F.WO, M, DM, DM}; pg8::StaticOrder S; S.init(M, DM, F.G, (int)blockIdx.x, MK_WGM_N8); pg8::EpiResGateBi8<true> E{F.x, F.XB, DM, F.MOD + 2 * DM, NMOD, SEQ, F.HSCALE, F.WSCO};
        pg8::gemm_phase<pg8::EpiResGateBi8<true>, pg8::StaticOrder, true, true, 2>(ldsl + RING_OFF, g, S, E, F.wave0); SEAM(4); }
    if (IN(5)) { for (int rep_ = 0; rep_ < 1 + ((MK_DUP_MASK >> 5) & 1); ++rep_) { if (rep_) GRID_BAR(); phase_norm<true, true>(F, F.XB, F.ffn_norm, 0, 3, 4, F.HB); } SEAM(5); }
    if (IN(6)) { for (int rep_ = 0; rep_ < 1 + ((MK_DUP_MASK >> 6) & 1); ++rep_) { if (rep_) GRID_BAR(); pg8::Gemm g{F.HB, F.WFI, M, 2 * DFF, DM}; pg8::StaticOrder S; S.init(M, 2 * DFF, F.G, (int)blockIdx.x, MK_WGM_FI); pg8::EpiSwiGLUi8f8 E{(unsigned char*)F.HID, DFF, F.HSCALE, F.WSCFI};
        pg8::gemm_phase<pg8::EpiSwiGLUi8f8, pg8::StaticOrder, true, true, 2>(ldsl + RING_OFF, g, S, E, F.wave0); } SEAM(6); }
    if (IN(7)) { pg8::Gemm g{F.HID, F.WFO, M, DM, DFF}; pg8::StaticOrder S; S.init(M, DM, F.G, (int)blockIdx.x, MK_WGM_N8); pg8::EpiResGateB<false> E{F.XB, F.XB, DM, F.MOD + 5 * DM, NMOD, SEQ, 1.0f / 64.0f};
        pg8::gemm_phase<pg8::EpiResGateB<false>, pg8::StaticOrder, true, true, 1>(ldsl + RING_OFF, g, S, E, F.wave0); SEAM(7); }
    if (IN(8)) { phase_norm<(MK_QKV1_I8 != 0), true>(F, F.XB, F.attn_norm + DM, 1, 0, 1, F.HB); SEAM(8); }
#if MK_QKV1_I8
    if (IN(9)) { for (int rep_ = 0; rep_ < 1 + ((MK_DUP_MASK >> 9) & 1); ++rep_) { if (rep_) GRID_BAR();
        const bf16* W1 = F.WQKV + (size_t)NQKV * DM;
        { pg8::Gemm g{F.HB, W1, M, QKP, DM}; pg8::StaticOrder S; S.init(M, QKP, F.G, (int)blockIdx.x, MK_WGM_QK); pg8::EpiBf16i8 E{F.QK, QKP, F.HSCALE, F.WSCQKV};
          pg8::gemm_phase<pg8::EpiBf16i8, pg8::StaticOrder, true, true, 2>(ldsl + RING_OFF, g, S, E, F.wave0); }
        { pg8::Gemm g{(const bf16*)((const unsigned char*)W1 + (size_t)QKP * DM), F.HB, DM, M, DM}; pg8::StaticOrder S; S.init(DM, M, F.G, (int)blockIdx.x, MK_WGM_VT); pg8::EpiBf16i8 E{F.VT, M, F.WSCQKV + QKP, F.HSCALE};
          pg8::gemm_phase<pg8::EpiBf16i8, pg8::StaticOrder, true, true, 2>(ldsl + RING_OFF, g, S, E, F.wave0); } } SEAM(9); }
#else
    if (IN(9)) { for (int rep_ = 0; rep_ < 1 + ((MK_DUP_MASK >> 9) & 1); ++rep_) { if (rep_) GRID_BAR();
        { pg8::Gemm g{F.HB, F.WQKV + (size_t)NQKV * DM, M, QKP, DM}; pg8::StaticOrder S; S.init(M, QKP, F.G, (int)blockIdx.x, MK_WGM_QK); pg8::EpiBf16 E{F.QK, QKP};
          pg8::gemm_phase<pg8::EpiBf16, pg8::StaticOrder, true, true>(ldsl + RING_OFF, g, S, E, F.wave0); }
        { pg8::Gemm g{F.WQKV + (size_t)NQKV * DM + (size_t)QKP * DM, F.HB, DM, M, DM}; pg8::StaticOrder S; S.init(DM, M, F.G, (int)blockIdx.x, MK_WGM_VT); pg8::EpiBf16 E{F.VT, M};
          pg8::gemm_phase<pg8::EpiBf16, pg8::StaticOrder, true, true>(ldsl + RING_OFF, g, S, E, F.wave0); } } SEAM(9); }
#endif
    if (IN(10)) { phase_qknorm(F); SEAM(10); }
    if (IN(11)) { for (int rep_ = 0; rep_ < 1 + ((MK_DUP_MASK >> 11) & 1); ++rep_) { if (rep_) GRID_BAR(); phase_moba(F); } GRID_BAR(); fresh_ids(F); phase_rowq(F, F.AO, (unsigned char*)F.HB); SEAM(11); }
    if (IN(12)) { pg8::Gemm g{F.HB, (const bf16*)((const unsigned char*)F.WO + (size_t)DM * DM), M, DM, DM}; pg8::StaticOrder S; S.init(M, DM, F.G, (int)blockIdx.x, MK_WGM_N8); pg8::EpiResGateBi8<false> E{F.XB, F.XB, DM, F.MOD + (size_t)8 * NMOD + 2 * DM, NMOD, SEQ, F.HSCALE, F.WSCO + DM};
        pg8::gemm_phase<pg8::EpiResGateBi8<false>, pg8::StaticOrder, true, true, 2>(ldsl + RING_OFF, g, S, E, F.wave0); SEAM(12); }
    if (IN(13)) { phase_router(F, F.XB); SEAM(13); }
    if (IN(14)) { for (int rep_ = 0; rep_ < 1 + ((MK_DUP_MASK >> 14) & 1); ++rep_) { if (rep_) GRID_BAR(); pg8::Gemm g{F.HSORT, F.WMI, 0, 0, DM}; pg8::MoeOrder S; moe_setup(F, S, 2 * DFE / 256, ECAP / 256, 2 * DFE / 256); pg8::EpiSwiGLU8 E{(unsigned char*)F.HID2, DFE, 1.0f / 64.0f};
        pg8::gemm_phase<pg8::EpiSwiGLU8, pg8::MoeOrder, true, true, 1>(ldsl + RING_OFF, g, S, E, F.wave0); } SEAM(14); }
    if (IN(15)) { for (int rep_ = 0; rep_ < 1 + ((MK_DUP_MASK >> 15) & 1); ++rep_) { if (rep_) GRID_BAR();
        { pg8::Gemm g{F.HID2, F.WMO, 0, 0, DFE}; pg8::MoeOrder S; moe_setup(F, S, DM / 256, 0, DM / 256); if (S.R > 128) { S.R = 128; S.nwg = 128 * S.nN; }
          pg8::EpiBf16RowScale E{F.YP, DM, F.GWC, 1.0f / 128.0f};
          pg8::gemm_phase<pg8::EpiBf16RowScale, pg8::MoeOrder, true, true, 1>(ldsl + RING_OFF, g, S, E, F.wave0); }
        { pg8::MoeOrder S0; moe_setup(F, S0, DM / 256, 0, DM / 256);
          pg8::MoeTailOrder S; S.G = F.G; S.c = (int)blockIdx.x; S.R = S0.R; S.kchunk = DFE / 4; S.p1 = S0.p1; S.p2 = S0.p2; S.p3 = S0.p3; S.p4 = S0.p4; S.p5 = S0.p5; S.p6 = S0.p6; S.p7 = S0.p7;
          pg8::Gemm g{F.HID2, F.WMO, 0, 0, DFE / 4, DFE}; pg8::EpiF32RowScale E{F.YT, DM, F.GWC, 1.0f / 128.0f};
          pg8::gemm_phase<pg8::EpiF32RowScale, pg8::MoeTailOrder, true, true, 1>(ldsl + RING_OFF, g, S, E, F.wave0); } } SEAM(15); }
    if (IN(16)) { phase_combine(F, F.XB, F.out); }
#undef IN
#undef SEAM
}

extern "C" void kernel_launch(void* const* d_in, const int* in_sizes, int n_in, void* d_out, int out_size, void* d_ws, size_t ws_size, hipStream_t stream) {
    static int grid = 0;
    if (grid == 0) {
        if (n_in != 15 || in_sizes[0] != M * DM || out_size != M * DM || ws_size < WS_END) { fprintf(stderr, "kernel_launch: unexpected shapes (n_in %d, in0 %d, out %d, ws %zu < %zu); nothing launched\n", n_in, n_in > 0 ? in_sizes[0] : -1, out_size, ws_size, (size_t)WS_END); grid = -1; return; }
        int dev = 0, cus = 0, per_cu = 0;
        if (hipGetDevice(&dev) != hipSuccess || hipDeviceGetAttribute(&cus, hipDeviceAttributeMultiprocessorCount, dev) != hipSuccess) { grid = -1; return; }
        if (hipFuncSetAttribute((const void*)fwd, hipFuncAttributeMaxDynamicSharedMemorySize, LDS_BYTES) != hipSuccess) { fprintf(stderr, "kernel_launch: hipFuncSetAttribute failed\n"); grid = -1; return; }
        if (hipOccupancyMaxActiveBlocksPerMultiprocessor(&per_cu, (const void*)fwd, NWAVES * 64, LDS_BYTES) != hipSuccess || per_cu < 1) fprintf(stderr, "kernel_launch: occupancy query reports %d\n", per_cu);
        (void)hipGetLastError();
        grid = cus;
    }
    if (grid < 0) return;
    if (hipMemsetAsync((char*)d_ws + WS_CTL, 0, CTL_ZERO_BYTES, stream) != hipSuccess) { fprintf(stderr, "kernel_launch: memset failed\n"); return; }
    Args a{};
    for (int i = 0; i < 15; ++i) a.in[i] = (const float*)d_in[i];
    a.out = (float*)d_out; a.ws = (unsigned char*)d_ws;
#if MK_ONE_LAUNCH
    a.ph_lo = 0; a.ph_hi = NPHASE;
    hipLaunchKernelGGL(fwd, dim3(grid), dim3(NWAVES * 64), LDS_BYTES, stream, a);
#else
    for (int p = 0; p < NPHASE; ++p) { a.ph_lo = p; a.ph_hi = p + 1; hipLaunchKernelGGL(fwd, dim3(grid), dim3(NWAVES * 64), LDS_BYTES, stream, a); }
#endif
    const hipError_t le = hipPeekAtLastError();
    if (le != hipSuccess) fprintf(stderr, "kernel_launch: launch failed: %s\n", hipGetErrorName(le));
}
```
